# Optimizing an MI355X kernel written in HIP

```python
import jax, jax.numpy as jnp
from jax import lax
import numpy as np

D_MODEL = 1024
BATCH = 4
SEQ = 4096
DEPTH = 2

N_CONV_LAYERS = DEPTH // 2
N_ATTN_LAYERS = DEPTH - N_CONV_LAYERS
CONV_WIDTH = 3
HEAD_DIM = 64
N_HEADS = D_MODEL // HEAD_DIM
BRANCHES = ((128, 1), (512, 4), (2048, 16))
N_BRANCHES = len(BRANCHES)
Q_WIDTH = N_BRANCHES * N_HEADS * HEAD_DIM
D_FF = -(-8 * D_MODEL // (3 * 256)) * 256
ROPE_THETA = 10000.0
RMS_EPS = 1e-6
NEG_INF = -1e30

kernel_name = "yoco_shortconv_dilated_attention_trunk"


def rms_norm(x, g):
    xf = x.astype(jnp.float32)
    y = xf * lax.rsqrt(jnp.mean(xf * xf, axis=-1, keepdims=True) + RMS_EPS)
    return (y * g.astype(jnp.float32)).astype(x.dtype)


def rope(t, positions):
    half = HEAD_DIM // 2
    inv_freq = ROPE_THETA ** (-jnp.arange(half, dtype=jnp.float32) / half)
    ang = positions.astype(jnp.float32)[..., None] * inv_freq
    cos = jnp.cos(ang)[:, :, None, :]
    sin = jnp.sin(ang)[:, :, None, :]
    t1 = t[..., :half].astype(jnp.float32)
    t2 = t[..., half:].astype(jnp.float32)
    out = jnp.concatenate([t1 * cos - t2 * sin, t2 * cos + t1 * sin], axis=-1)
    return out.astype(t.dtype)


def short_conv_mixer(x, w_in, conv_w, w_out):
    b_gate, c_gate, h = jnp.split(x @ w_in, 3, axis=-1)
    u = c_gate * h
    rhs = conv_w[:, None, :].astype(u.dtype)
    conv = lax.conv_general_dilated(
        u, rhs, window_strides=(1,), padding=[(CONV_WIDTH - 1, 0)],
        dimension_numbers=("NWC", "WIO", "NWC"), feature_group_count=u.shape[-1])
    return (b_gate * conv) @ w_out


def swiglu(x, w_gate_up, w_down):
    g, u = jnp.split(x @ w_gate_up, 2, axis=-1)
    return (jax.nn.silu(g) * u) @ w_down


def dilated_branch(q, k, v, window, dilation):
    band = window // dilation
    B, S, H, Dh = q.shape
    chunk = dilation * band
    Sp = -(-S // chunk) * chunk
    nb = Sp // chunk
    pad = ((0, 0), (0, Sp - S), (0, 0), (0, 0))

    def to_blocks(t):
        t = jnp.pad(t, pad).reshape(B, nb, band, dilation, H, Dh)
        return t.transpose(0, 3, 4, 1, 2, 5)

    def with_prev(t):
        prev = jnp.pad(t, ((0, 0), (0, 0), (0, 0), (1, 0), (0, 0), (0, 0)))[:, :, :, :-1]
        return jnp.concatenate([prev, t], axis=4)

    qb = to_blocks(q * (HEAD_DIM ** -0.5))
    kk = with_prev(to_blocks(k))
    vv = with_prev(to_blocks(v))
    s = jnp.einsum("brhnqd,brhnkd->brhnqk", qb, kk).astype(jnp.float32)
    qi = jnp.arange(band)[:, None]
    kj = jnp.arange(2 * band)[None, :]
    dist = qi + band - kj
    in_band = (dist >= 0) & (dist <= band)
    has_prev = (kj >= band)[None] | (jnp.arange(nb)[:, None, None] > 0)
    mask = in_band[None] & has_prev
    s = jnp.where(mask, s, NEG_INF)
    m = jnp.max(s, axis=-1)
    p = jnp.exp(s - m[..., None])
    l = jnp.sum(p, axis=-1)
    o = jnp.einsum("brhnqk,brhnkd->brhnqd", p, vv.astype(jnp.float32)) / l[..., None]
    lse = m + jnp.log(l)
    o = o.transpose(0, 3, 4, 1, 2, 5).reshape(B, Sp, H, Dh)[:, :S]
    lse = lse.transpose(0, 3, 4, 1, 2).reshape(B, Sp, H)[:, :S]
    return o, lse


def dilated_attention_mixer(x, positions, k_sh, v_sh, w_q, w_o):
    B, S, _ = x.shape
    q = (x @ w_q).reshape(B, S, N_BRANCHES * N_HEADS, HEAD_DIM)
    q = rope(q, positions).reshape(B, S, N_BRANCHES, N_HEADS, HEAD_DIM)
    outs, lses = [], []
    for g, (window, dilation) in enumerate(BRANCHES):
        o, lse = dilated_branch(q[:, :, g], k_sh[:, :, g], v_sh[:, :, g], window, dilation)
        outs.append(o)
        lses.append(lse)
    wts = jax.nn.softmax(jnp.stack(lses, axis=0), axis=0)
    o = jnp.einsum("gbsh,gbshd->bshd", wts, jnp.stack(outs, axis=0))
    return o.astype(x.dtype).reshape(B, S, N_HEADS * HEAD_DIM) @ w_o


def shared_kv(h, positions, kv_norm, w_kv):
    B, S, _ = h.shape
    kv = (rms_norm(h, kv_norm) @ w_kv).reshape(B, S, 2, N_BRANCHES * N_HEADS, HEAD_DIM)
    k = rope(kv[:, :, 0], positions).reshape(B, S, N_BRANCHES, N_HEADS, HEAD_DIM)
    v = kv[:, :, 1].reshape(B, S, N_BRANCHES, N_HEADS, HEAD_DIM)
    return k, v


def setup_inputs(seed: int = 0) -> dict:
    key = jax.random.key(seed)
    ks = jax.random.split(key, 20)
    f32 = jnp.float32

    def w(k, shape, fan_in):
        return jax.random.normal(k, shape, f32) * (fan_in ** -0.5)

    def gain(k, shape):
        return 1.0 + 0.05 * jax.random.normal(k, shape, f32)

    x = jax.random.normal(ks[0], (BATCH, SEQ, D_MODEL), f32)
    offset = jax.random.randint(ks[1], (BATCH, 1), 0, 4096, dtype=jnp.int32)
    positions = offset + jnp.arange(SEQ, dtype=jnp.int32)[None, :]
    nA, nB = N_CONV_LAYERS, N_ATTN_LAYERS
    return {
        "x": x,
        "positions": positions,
        "mix_norm_pre": gain(ks[2], (DEPTH, D_MODEL)),
        "mix_norm_post": gain(ks[3], (DEPTH, D_MODEL)),
        "ffn_norm_pre": gain(ks[4], (DEPTH, D_MODEL)),
        "ffn_norm_post": gain(ks[5], (DEPTH, D_MODEL)),
        "ffn_w_gate_up": w(ks[6], (DEPTH, D_MODEL, 2 * D_FF), D_MODEL),
        "ffn_w_down": w(ks[7], (DEPTH, D_FF, D_MODEL), D_FF),
        "conv_w_in": w(ks[8], (nA, D_MODEL, 3 * D_MODEL), D_MODEL),
        "conv_w": w(ks[9], (nA, CONV_WIDTH, D_MODEL), CONV_WIDTH),
        "conv_w_out": w(ks[10], (nA, D_MODEL, D_MODEL), D_MODEL),
        "kv_norm": gain(ks[11], (D_MODEL,)),
        "w_kv": w(ks[12], (D_MODEL, 2 * Q_WIDTH), D_MODEL),
        "w_q": w(ks[13], (nB, D_MODEL, Q_WIDTH), D_MODEL),
        "w_o": w(ks[14], (nB, N_HEADS * HEAD_DIM, D_MODEL), N_HEADS * HEAD_DIM),
    }


def reference(x, positions, mix_norm_pre, mix_norm_post, ffn_norm_pre, ffn_norm_post,
              ffn_w_gate_up, ffn_w_down, conv_w_in, conv_w, conv_w_out,
              kv_norm, w_kv, w_q, w_o):
    h = x
    for layer in range(DEPTH):
        if layer == N_CONV_LAYERS:
            k_sh, v_sh = shared_kv(h, positions, kv_norm, w_kv)
        hn = rms_norm(h, mix_norm_pre[layer])
        if layer < N_CONV_LAYERS:
            y = short_conv_mixer(hn, conv_w_in[layer], conv_w[layer], conv_w_out[layer])
        else:
            j = layer - N_CONV_LAYERS
            y = dilated_attention_mixer(hn, positions, k_sh, v_sh, w_q[j], w_o[j])
        h = h + rms_norm(y, mix_norm_post[layer])
        f = swiglu(rms_norm(h, ffn_norm_pre[layer]), ffn_w_gate_up[layer], ffn_w_down[layer])
        h = h + rms_norm(f, ffn_norm_post[layer])
    return h
```

```cpp
#include <hip/hip_runtime.h>
#include <cstdio>
#include <cstdint>

#ifndef MK_PER_PHASE
#define MK_PER_PHASE 1
#endif

#ifndef EN_ALL
#define EN_ALL 1
#endif
#ifndef EN_P0
#define EN_P0 EN_ALL
#endif
#ifndef EN_G1
#define EN_G1 EN_ALL
#endif
#ifndef EN_CONV
#define EN_CONV EN_ALL
#endif
#ifndef EN_GF32
#define EN_GF32 EN_ALL
#endif
#ifndef EN_ROW
#define EN_ROW EN_ALL
#endif
#ifndef EN_UP
#define EN_UP EN_ALL
#endif
#ifndef EN_KVQ
#define EN_KVQ EN_ALL
#endif
#ifndef EN_ATT
#define EN_ATT EN_ALL
#endif
#ifndef EN_MIX
#define EN_MIX EN_ALL
#endif
#define LAS __attribute__((address_space(3)))
#define GAS __attribute__((address_space(1)))
typedef unsigned short bf16_t;
typedef short bf16x8 __attribute__((ext_vector_type(8)));
typedef short s16x4 __attribute__((ext_vector_type(4)));
typedef float f32x4 __attribute__((ext_vector_type(4)));
typedef float f32x2 __attribute__((ext_vector_type(2)));
typedef float f32x16 __attribute__((ext_vector_type(16)));
typedef unsigned u32x4 __attribute__((ext_vector_type(4)));
typedef unsigned u32x2 __attribute__((ext_vector_type(2)));

constexpr int BATCH = 4, SEQ = 4096, D = 1024, M = BATCH * SEQ, DFF = 2816, NQ = 3072, NH = 16, HD = 64;
constexpr int MH = M / 2;
constexpr float RMS_EPS = 1e-6f;
constexpr float QSCALE = 0.125f * 1.4426950408889634f;

namespace pg8 {
constexpr int BM = 256, BK = 64, HALF = 128, HTB = HALF * BK * 2, STAGE_BYTES = 8 * HTB, NXCD = 8, WGM = 8;
__host__ __device__ __forceinline__ int lds_byte(int r, int c) { const int st = (r >> 4) * 2 + (c >> 5), rr = r & 15, cc = c & 31, ob = rr * 64 + cc * 2; return st * 1024 + (ob ^ (((ob >> 9) & 1) << 5)); }
__host__ __device__ __forceinline__ void stage_rc(int b, int& R, int& C) { const int st = b / 1024, sb = b % 1024, swz = sb ^ (((sb >> 9) & 1) << 5); R = (st >> 1) * 16 + swz / 64; C = (st & 1) * 32 + (swz % 64) / 2; }
__host__ __device__ __forceinline__ int perm32(int rho) { const int n = rho >> 4, i = rho & 15; return 8 * (i >> 2) + 4 * n + (i & 3); }

struct Unit { int pm, pn; };
struct Gemm { const bf16_t* A; const bf16_t* Bt; int M, N, K; };

struct StaticOrder {
    int nM, nN, nwg, G, c;
    __host__ __device__ void init(int M_, int N_, int G_, int c_) { nM = M_ / BM; nN = N_ / BM; nwg = nM * nN; G = G_; c = c_; }
    __host__ __device__ bool next(int i, Unit& u) const {
        const long L = (long)i * G + c; if (L >= nwg) return false;
        int wgid = (int)L; { const int q = nwg / NXCD, r = nwg % NXCD, xcd = wgid % NXCD, off = wgid / NXCD; wgid = (xcd < r ? xcd * (q + 1) : r * (q + 1) + (xcd - r) * q) + off; }
        const int nig = WGM * nN, gid = wgid / nig, fm = gid * WGM, gsz = (nM - fm) < WGM ? (nM - fm) : WGM;
        u.pm = fm + ((wgid % nig) % gsz); u.pn = (wgid % nig) / gsz; return true;
    }
    __device__ __forceinline__ void a_ready(const Unit&) const {}
    __device__ __forceinline__ void done(const Unit&) const {}
};

__device__ __forceinline__ unsigned cvt_pk_bf16(float lo, float hi) { unsigned r; asm volatile("v_cvt_pk_bf16_f32 %0, %1, %2" : "=v"(r) : "v"(lo), "v"(hi)); return r; }

struct EpiF32 {
    static constexpr bool PERM = false, AFTER_DRAIN = false;
    float* C; int ldc;
    __device__ __forceinline__ void operator()(const f32x4 (&acc)[2][2][4][2], const Unit& u, int wr, int wc, int fr, int fq) const {
        const int row0 = u.pm * BM + wr * 64 + fr, col0 = u.pn * BM + wc * 32 + 4 * fq;
#pragma unroll
        for (int ai = 0; ai < 2; ++ai)
#pragma unroll
            for (int m = 0; m < 4; ++m) { float* rowp = C + (size_t)(row0 + ai * HALF + m * 16) * ldc + col0;
#pragma unroll
                for (int bj = 0; bj < 2; ++bj)
#pragma unroll
                    for (int n = 0; n < 2; ++n) *(f32x4*)(rowp + bj * HALF + n * 16) = acc[ai][bj][m][n]; }
    }
};
struct EpiConvIn {
    static constexpr bool PERM = true, AFTER_DRAIN = false;
    bf16_t* Bg; bf16_t* U;
    __device__ __forceinline__ void operator()(const f32x4 (&acc)[2][2][4][2], const Unit& u, int wr, int wc, int fr, int fq) const {
        const int row0 = u.pm * BM + wr * 64 + fr;
        if (u.pn < 4) {
            const int col0 = u.pn * BM + wc * 32 + 8 * fq;
#pragma unroll
            for (int ai = 0; ai < 2; ++ai)
#pragma unroll
                for (int m = 0; m < 4; ++m) { bf16_t* rowp = Bg + (size_t)(row0 + ai * HALF + m * 16) * D + col0;
#pragma unroll
                    for (int bj = 0; bj < 2; ++bj) { const f32x4 v0 = acc[ai][bj][m][0], v1 = acc[ai][bj][m][1];
                        u32x4 w; w.x = cvt_pk_bf16(v0[0], v0[1]); w.y = cvt_pk_bf16(v0[2], v0[3]); w.z = cvt_pk_bf16(v1[0], v1[1]); w.w = cvt_pk_bf16(v1[2], v1[3]);
                        *(u32x4*)(rowp + bj * HALF) = w; } }
        } else {
            const int col0 = (u.pn - 4) * HALF + wc * 32 + 8 * fq;
#pragma unroll
            for (int ai = 0; ai < 2; ++ai)
#pragma unroll
                for (int m = 0; m < 4; ++m) { bf16_t* rowp = U + (size_t)(row0 + ai * HALF + m * 16) * D + col0;
                    const f32x4 v0 = acc[ai][0][m][0] * acc[ai][1][m][0], v1 = acc[ai][0][m][1] * acc[ai][1][m][1];
                    u32x4 w; w.x = cvt_pk_bf16(v0[0], v0[1]); w.y = cvt_pk_bf16(v0[2], v0[3]); w.z = cvt_pk_bf16(v1[0], v1[1]); w.w = cvt_pk_bf16(v1[2], v1[3]);
                    *(u32x4*)rowp = w; }
        }
    }
};
struct EpiSwiGLU {
    static constexpr bool PERM = true, AFTER_DRAIN = false;
    bf16_t* Act;
    __device__ __forceinline__ static f32x4 silu_mul(f32x4 g, f32x4 u) {
        f32x4 o;
#pragma unroll
        for (int i = 0; i < 4; ++i) { const float e = __builtin_amdgcn_exp2f(g[i] * -1.4426950408889634f); o[i] = g[i] * __builtin_amdgcn_rcpf(1.0f + e) * u[i]; }
        return o;
    }
    __device__ __forceinline__ void operator()(const f32x4 (&acc)[2][2][4][2], const Unit& u, int wr, int wc, int fr, int fq) const {
        const int row0 = u.pm * BM + wr * 64 + fr, col0 = u.pn * HALF + wc * 32 + 8 * fq;
#pragma unroll
        for (int ai = 0; ai < 2; ++ai)
#pragma unroll
            for (int m = 0; m < 4; ++m) { bf16_t* rowp = Act + (size_t)(row0 + ai * HALF + m * 16) * DFF + col0;
                const f32x4 v0 = silu_mul(acc[ai][0][m][0], acc[ai][1][m][0]), v1 = silu_mul(acc[ai][0][m][1], acc[ai][1][m][1]);
                u32x4 w; w.x = cvt_pk_bf16(v0[0], v0[1]); w.y = cvt_pk_bf16(v0[2], v0[3]); w.z = cvt_pk_bf16(v1[0], v1[1]); w.w = cvt_pk_bf16(v1[2], v1[3]);
                *(u32x4*)rowp = w; }
    }
};
struct EpiKVQ {
    static constexpr bool PERM = true, AFTER_DRAIN = false;
    bf16_t* Kb; bf16_t* Vb; bf16_t* Qb; const float* rope;
    __device__ __forceinline__ void operator()(const f32x4 (&acc)[2][2][4][2], const Unit& u, int wr, int wc, int fr, int fq) const {
        const int part = u.pn / 12, tile = u.pn - part * 12;
        const int row0 = u.pm * BM + wr * 64 + fr, col0 = (4 * tile + wc) * HD + 8 * fq;
        bf16_t* base = Kb + (size_t)part * ((size_t)MH * NQ);
#pragma unroll
        for (int ai = 0; ai < 2; ++ai)
#pragma unroll
            for (int m = 0; m < 4; ++m) { const int row = row0 + ai * HALF + m * 16; bf16_t* rowp = base + (size_t)row * NQ + col0;
                f32x4 a0 = acc[ai][0][m][0], a1 = acc[ai][0][m][1], b0 = acc[ai][1][m][0], b1 = acc[ai][1][m][1];
                if (part != 1) { const float* rp = rope + (size_t)row * 64 + 8 * fq;
                    const f32x4 c0 = *(const f32x4*)rp, c1 = *(const f32x4*)(rp + 4), s0 = *(const f32x4*)(rp + 32), s1 = *(const f32x4*)(rp + 36);
                    const f32x4 x0 = a0 * c0 - b0 * s0, x1 = a1 * c1 - b1 * s1, y0 = b0 * c0 + a0 * s0, y1 = b1 * c1 + a1 * s1;
                    a0 = x0; a1 = x1; b0 = y0; b1 = y1; }
                u32x4 w; w.x = cvt_pk_bf16(a0[0], a0[1]); w.y = cvt_pk_bf16(a0[2], a0[3]); w.z = cvt_pk_bf16(a1[0], a1[1]); w.w = cvt_pk_bf16(a1[2], a1[3]);
                *(u32x4*)rowp = w;
                w.x = cvt_pk_bf16(b0[0], b0[1]); w.y = cvt_pk_bf16(b0[2], b0[3]); w.z = cvt_pk_bf16(b1[0], b1[1]); w.w = cvt_pk_bf16(b1[2], b1[3]);
                *(u32x4*)(rowp + 32) = w; }
    }
};

template <class Epi, class Sched, bool ALIGN_EPI = false, bool SP2 = false>
__device__ __forceinline__ void gemm_phase(LAS unsigned char* lds, const Gemm g, const Sched& S, const Epi& E) {
    const int tid = threadIdx.x, wid = __builtin_amdgcn_readfirstlane(tid >> 6), lane = tid & 63, wr = wid >> 2, wc = wid & 3, fr = lane & 15, fq = lane >> 4;
    const int K = g.K, nt = K / BK;
    unsigned voffA[2], voffB[2];
#pragma unroll
    for (int i = 0; i < 2; ++i) { int R, C; stage_rc(tid * 16 + i * 8192, R, C); const int Rb = Epi::PERM ? ((R & ~31) + perm32(R & 31)) : R;
        voffA[i] = (unsigned)(R * K + C) * 2u; voffB[i] = (unsigned)(Rb * K + C) * 2u; }
    const size_t kstep = (size_t)(BK * 2);
    const size_t hstep = (size_t)HALF * K * 2;
    const size_t tstep = 2 * hstep;
    const unsigned ldsw = (unsigned)wid * 1024u;
    const int aoff = lds_byte(wr * 64 + fr, fq * 8), boff = lds_byte(wc * 32 + fr, fq * 8);
#define PG8_SA(b, h) (((b) * 2 + (h)) * HTB)
#define PG8_SB(b, h) ((4 + (b) * 2 + (h)) * HTB)
#define PG8_STAGE(bufoff, gbase, voff) do { _Pragma("unroll") for (int _i = 0; _i < 2; ++_i) \
        __builtin_amdgcn_global_load_lds((const unsigned*)((const char*)(gbase) + (voff)[_i]), (LAS unsigned*)(lds + (bufoff) + ldsw + _i * 8192), 16, 0, 0); } while (0)
#define PG8_LDA(dst, b, h) do { _Pragma("unroll") for (int m = 0; m < 4; ++m) _Pragma("unroll") for (int k = 0; k < 2; ++k) dst[m][k] = *(const LAS bf16x8*)(lds + PG8_SA(b, h) + aoff + m * 2048 + k * 1024); } while (0)
#define PG8_LDB(dst, b, h) do { _Pragma("unroll") for (int n = 0; n < 2; ++n) _Pragma("unroll") for (int k = 0; k < 2; ++k) dst[n][k] = *(const LAS bf16x8*)(lds + PG8_SB(b, h) + boff + n * 2048 + k * 1024); } while (0)
#define PG8_MMA(ai, bj, At, Bt) do { __builtin_amdgcn_s_setprio(1); _Pragma("unroll") for (int m = 0; m < 4; ++m) _Pragma("unroll") for (int n = 0; n < 2; ++n) _Pragma("unroll") for (int k = 0; k < 2; ++k) \
        acc[ai][bj][m][n] = __builtin_amdgcn_mfma_f32_16x16x32_bf16(Bt[n][k], At[m][k], acc[ai][bj][m][n], 0, 0, 0); __builtin_amdgcn_s_setprio(0); } while (0)
#define PG8_WAIT_V(n) asm volatile("s_waitcnt vmcnt(" #n ")" ::: "memory")
#define PG8_WAIT_L(n) asm volatile("s_waitcnt lgkmcnt(" #n ")" ::: "memory")
#define PG8_BAR __builtin_amdgcn_s_barrier()
#define PG8_SCHED __builtin_amdgcn_sched_barrier(0)
    Unit cur, nxt; int ui = 0;
    if (!S.next(0, cur)) return;
    f32x4 acc[2][2][4][2];
#pragma unroll
    for (int a = 0; a < 2; ++a)
#pragma unroll
        for (int b = 0; b < 2; ++b)
#pragma unroll
            for (int m = 0; m < 4; ++m)
#pragma unroll
                for (int n = 0; n < 2; ++n) acc[a][b][m][n] = (f32x4){0.f, 0.f, 0.f, 0.f};
    bf16x8 At[4][2], B0[2][2], B1[2][2];
    const char* cA = (const char*)g.A + (size_t)cur.pm * tstep; const char* cB = (const char*)g.Bt + (size_t)cur.pn * tstep;
    S.a_ready(cur);
    if constexpr (SP2) {
        PG8_STAGE(PG8_SB(0, 0), cB, voffB); PG8_STAGE(PG8_SB(0, 1), cB + hstep, voffB); PG8_STAGE(PG8_SA(0, 0), cA, voffA); PG8_STAGE(PG8_SA(0, 1), cA + hstep, voffA);
        if (wr == 1) PG8_BAR;
        PG8_WAIT_V(2); PG8_BAR;
        PG8_STAGE(PG8_SB(1, 0), cB + kstep, voffB); PG8_STAGE(PG8_SA(1, 0), cA + kstep, voffA); PG8_STAGE(PG8_SB(1, 1), cB + hstep + kstep, voffB);
        PG8_WAIT_V(6); PG8_BAR;
    } else {
        PG8_STAGE(PG8_SB(0, 0), cB, voffB); PG8_STAGE(PG8_SA(0, 0), cA, voffA); PG8_STAGE(PG8_SB(0, 1), cB + hstep, voffB); PG8_STAGE(PG8_SA(0, 1), cA + hstep, voffA);
        if (wr == 1) PG8_BAR;
        PG8_WAIT_V(4); PG8_BAR;
        PG8_STAGE(PG8_SB(1, 0), cB + kstep, voffB); PG8_STAGE(PG8_SA(1, 0), cA + kstep, voffA); PG8_STAGE(PG8_SB(1, 1), cB + hstep + kstep, voffB);
        PG8_WAIT_V(6); PG8_BAR;
    }
    for (;;) {
        const bool has_next = S.next(ui + 1, nxt);
        const char* nA = has_next ? (const char*)g.A + (size_t)nxt.pm * tstep : cA; const char* nB = has_next ? (const char*)g.Bt + (size_t)nxt.pn * tstep : cB;
        for (int t = 0; t < nt; t += 2) {
            const bool last = (t == nt - 2);
            const char* a1 = cA + (size_t)(t + 1) * kstep;
            const char* a2 = last ? nA : cA + (size_t)(t + 2) * kstep; const char* b2 = last ? nB : cB + (size_t)(t + 2) * kstep;
            const char* a3 = a2 + kstep; const char* b3 = b2 + kstep;
            if (last && has_next) S.a_ready(nxt);
            if constexpr (SP2) {
            PG8_LDB(B0, 0, 0); PG8_LDB(B1, 0, 1); PG8_SCHED; PG8_LDA(At, 0, 0); PG8_STAGE(PG8_SA(1, 1), a1 + hstep, voffA);
            PG8_WAIT_V(8); PG8_WAIT_L(0); PG8_BAR; PG8_MMA(0, 0, At, B0); PG8_MMA(0, 1, At, B1); PG8_BAR; PG8_SCHED;
            PG8_LDA(At, 0, 1); PG8_STAGE(PG8_SB(0, 0), b2, voffB); PG8_STAGE(PG8_SB(0, 1), b2 + hstep, voffB); PG8_STAGE(PG8_SA(0, 0), a2, voffA);
            PG8_WAIT_V(8); PG8_WAIT_L(0); PG8_BAR; PG8_MMA(1, 0, At, B0); PG8_MMA(1, 1, At, B1); PG8_BAR; PG8_SCHED;
            PG8_LDB(B0, 1, 0); PG8_LDB(B1, 1, 1); PG8_SCHED; PG8_LDA(At, 1, 0); PG8_STAGE(PG8_SA(0, 1), a2 + hstep, voffA);
            PG8_WAIT_V(8); PG8_WAIT_L(0); PG8_BAR; PG8_MMA(0, 0, At, B0); PG8_MMA(0, 1, At, B1); PG8_BAR; PG8_SCHED;
            PG8_LDA(At, 1, 1); PG8_STAGE(PG8_SB(1, 0), b3, voffB); PG8_STAGE(PG8_SB(1, 1), b3 + hstep, voffB); PG8_STAGE(PG8_SA(1, 0), a3, voffA);
            PG8_WAIT_V(8); PG8_WAIT_L(0); PG8_BAR; PG8_MMA(1, 0, At, B0); PG8_MMA(1, 1, At, B1); PG8_BAR; PG8_SCHED;
            } else {
            PG8_LDB(B0, 0, 0); PG8_SCHED; PG8_LDA(At, 0, 0); PG8_STAGE(PG8_SA(1, 1), a1 + hstep, voffA);
            PG8_WAIT_L(8); PG8_BAR; PG8_WAIT_L(0); PG8_MMA(0, 0, At, B0); PG8_BAR; PG8_SCHED;
            PG8_LDB(B1, 0, 1); PG8_STAGE(PG8_SB(0, 0), b2, voffB);
            PG8_BAR; PG8_WAIT_L(0); PG8_MMA(0, 1, At, B1); PG8_BAR;
            PG8_LDA(At, 0, 1); PG8_STAGE(PG8_SA(0, 0), a2, voffA);
            PG8_BAR; PG8_WAIT_L(0); PG8_MMA(1, 0, At, B0); PG8_BAR; PG8_SCHED;
            PG8_STAGE(PG8_SB(0, 1), b2 + hstep, voffB);
            PG8_WAIT_V(6); PG8_BAR; PG8_MMA(1, 1, At, B1); PG8_BAR;
            PG8_LDB(B0, 1, 0); PG8_SCHED; PG8_LDA(At, 1, 0); PG8_STAGE(PG8_SA(0, 1), a2 + hstep, voffA);
            PG8_WAIT_L(8); PG8_BAR; PG8_WAIT_L(0); PG8_MMA(0, 0, At, B0); PG8_BAR; PG8_SCHED;
            PG8_LDB(B1, 1, 1); PG8_STAGE(PG8_SB(1, 0), b3, voffB);
            PG8_BAR; PG8_WAIT_L(0); PG8_MMA(0, 1, At, B1); PG8_BAR;
            PG8_LDA(At, 1, 1); PG8_STAGE(PG8_SA(1, 0), a3, voffA);
            PG8_BAR; PG8_WAIT_L(0); PG8_MMA(1, 0, At, B0); PG8_BAR; PG8_SCHED;
            PG8_STAGE(PG8_SB(1, 1), b3 + hstep, voffB);
            PG8_WAIT_V(6); PG8_BAR; PG8_MMA(1, 1, At, B1); PG8_BAR;
            }
        }
        if constexpr (ALIGN_EPI) { if (wr == 0) PG8_BAR; }
        if constexpr (!Epi::AFTER_DRAIN) { E(acc, cur, wr, wc, fr, fq); S.done(cur); }
        if (!has_next) break;
#pragma unroll
        for (int a = 0; a < 2; ++a)
#pragma unroll
            for (int b = 0; b < 2; ++b)
#pragma unroll
                for (int m = 0; m < 4; ++m)
#pragma unroll
                    for (int n = 0; n < 2; ++n) acc[a][b][m][n] = (f32x4){0.f, 0.f, 0.f, 0.f};
        cur = nxt; cA = nA; cB = nB; ++ui;
        if constexpr (ALIGN_EPI) { if (wr == 1) PG8_BAR; }
    }
    PG8_WAIT_V(0);
    if constexpr (!ALIGN_EPI) { if (wr == 0) PG8_BAR; }
    PG8_BAR;
#undef PG8_SA
#undef PG8_SB
#undef PG8_STAGE
#undef PG8_LDA
#undef PG8_LDB
#undef PG8_MMA
#undef PG8_WAIT_V
#undef PG8_WAIT_L
#undef PG8_BAR
#undef PG8_SCHED
}
}

constexpr size_t MiB = 1u << 20;
constexpr size_t WS_CTL = 0, CTL_ZERO_BYTES = 64 * 1024;
constexpr size_t WS_ROPE = 1 * MiB;
constexpr size_t WS_WIN = 5 * MiB;
constexpr size_t WS_WOUT = 11 * MiB;
constexpr size_t WS_WGU0 = 13 * MiB;
constexpr size_t WS_WDN0 = 24 * MiB;
constexpr size_t WS_WKVQ = 24 * MiB + 5632 * 1024;
constexpr size_t WS_WO = WS_WKVQ + 18 * MiB;
constexpr size_t WS_WGU1 = WS_WO + 2 * MiB;
constexpr size_t WS_WDN1 = WS_WGU1 + 11 * MiB;
constexpr size_t WS_XN = 66 * MiB;
constexpr size_t WS_Y = 98 * MiB;
constexpr size_t WS_ACT = 162 * MiB;
constexpr size_t WS_K = 98 * MiB, WS_V = 146 * MiB, WS_Q = 194 * MiB; static_assert(WS_V - WS_K == (size_t)MH * NQ * 2 && WS_Q - WS_V == (size_t)MH * NQ * 2, "K|V|Q consecutive");
constexpr size_t WS_LSE = 250 * MiB;
constexpr size_t WS_END = 253 * MiB;
static_assert(WS_WDN1 + 5632 * 1024 == WS_XN && WS_Q + 48 * MiB <= WS_LSE && WS_ACT + (size_t)M * DFF * 2 <= WS_LSE, "d_ws map");

constexpr int RING_BYTES = 131072, MISC_OFF = RING_BYTES + 320, LDS_BYTES = 147456;
constexpr int NWAVES = 8;

#define XB_TMO      128
#define XB_XCNT(j)  (256  + 64 * (j))
#define XB_XSUB(j)  (1280 + 64 * (j))
#define XB_XGEN(j)  (2304 + 64 * (j))
#define XB_TOP      3328
#define XB_TOPGEN   3392
#define XCD_BAR_WORDS 3456
#define XB_SPIN_CAP (1u << 18)
__device__ __forceinline__ unsigned xb_ld(unsigned* p)              { return __hip_atomic_load(p, __ATOMIC_RELAXED, __HIP_MEMORY_SCOPE_AGENT); }
__device__ __forceinline__ unsigned xb_add(unsigned* p, unsigned v) { return __hip_atomic_fetch_add(p, v, __ATOMIC_RELAXED, __HIP_MEMORY_SCOPE_AGENT); }
__device__ __forceinline__ unsigned xb_xcc_id() { return (unsigned)__builtin_amdgcn_s_getreg((3 << 11) | 20) & 0xFu; }
#define XB_SPIN(cond, bar) do { unsigned _sp = 0; while (cond) { __builtin_amdgcn_s_sleep(1); \
    if ((++_sp & 255u) == 0u) { if (xb_ld(&(bar)[XB_TMO])) break; if (_sp > XB_SPIN_CAP) { atomicAdd(&(bar)[XB_TMO], 1u); break; } } } } while (0)
struct XcdBarrier { unsigned* bar; unsigned x; volatile LAS unsigned* st; };
__device__ __forceinline__ XcdBarrier xcd_barrier_post(unsigned* bar, volatile LAS unsigned* st) {
    XcdBarrier b; b.bar = bar; b.x = xb_xcc_id(); b.st = st;
    if (threadIdx.x == 0) (void)xb_add(&bar[XB_XCNT(b.x)], 1u);
    return b;
}
__device__ __forceinline__ void xcd_barrier_complete(unsigned* bar, unsigned x, unsigned& nloc, unsigned& nx) {
    const unsigned G = gridDim.x * gridDim.y * gridDim.z;
    unsigned sum, cnt, mine, sp = 0u;
    for (;;) {
        sum = 0u; cnt = 0u; mine = 0u;
#pragma unroll 1
        for (unsigned j = 0; j < 16; ++j) { const unsigned c = xb_ld(&bar[XB_XCNT(j)]); sum += c; cnt += (c > 0u) ? 1u : 0u; mine = (j == x) ? c : mine; }
        if (sum == G) break;
        __builtin_amdgcn_s_sleep(1);
        if ((++sp & 255u) == 0u) { if (xb_ld(&bar[XB_TMO])) break; if (sp > XB_SPIN_CAP) { atomicAdd(&bar[XB_TMO], 1u); break; } }
    }
    nloc = mine > 0u ? mine : 1u; nx = cnt > 0u ? cnt : 1u;
}
__device__ __forceinline__ void xcd_barrier(const XcdBarrier& b) {
    asm volatile("s_waitcnt vmcnt(0)" ::: "memory");
    __syncthreads();
    if (threadIdx.x == 0) {
        unsigned* bar = b.bar;
        __builtin_amdgcn_s_waitcnt(0);
        unsigned nloc = b.st[0], nx = b.st[1];
        if (nloc == 0u) { xcd_barrier_complete(bar, b.x, nloc, nx); b.st[0] = nloc; b.st[1] = nx; }
        const unsigned old = xb_add(&bar[XB_XSUB(b.x)], 1u);
        const unsigned gen = old / nloc;
        if (old + 1u == (gen + 1u) * nloc) {
            __builtin_amdgcn_fence(__ATOMIC_RELEASE, "agent");
            asm volatile("s_waitcnt vmcnt(0)" ::: "memory");
            const unsigned og = xb_add(&bar[XB_TOP], 1u);
            const unsigned tg = og / nx;
            if (og + 1u == (tg + 1u) * nx) xb_add(&bar[XB_TOPGEN], 1u);
            else XB_SPIN(xb_ld(&bar[XB_TOPGEN]) == tg, bar);
            __builtin_amdgcn_fence(__ATOMIC_ACQUIRE, "agent");
            xb_add(&bar[XB_XGEN(b.x)], 1u);
            asm volatile("s_waitcnt vmcnt(0)" ::: "memory");
        } else {
            XB_SPIN(xb_ld(&bar[XB_XGEN(b.x)]) == gen, bar);
            __builtin_amdgcn_fence(__ATOMIC_ACQUIRE, "agent");
            asm volatile("s_waitcnt vmcnt(0)" ::: "memory");
        }
    }
    __syncthreads();
}

__device__ __forceinline__ unsigned f2bf(float f) { unsigned u = __builtin_bit_cast(unsigned, f); return (u + 0x7fffu + ((u >> 16) & 1u)) >> 16; }
__device__ __forceinline__ unsigned pk2(float lo, float hi) { return f2bf(lo) | (f2bf(hi) << 16); }
__device__ __forceinline__ float bf_lo(unsigned w) { return __builtin_bit_cast(float, w << 16); }
__device__ __forceinline__ float bf_hi(unsigned w) { return __builtin_bit_cast(float, w & 0xffff0000u); }
__device__ __forceinline__ float wave_sum(float v) {
#pragma unroll
    for (int o = 1; o < 64; o <<= 1) v += __shfl_xor(v, o);
    return v;
}

struct Args {
    const float* x; const int* pos; const float* mix_pre; const float* mix_post; const float* ffn_pre; const float* ffn_post;
    const float* w_gu; const float* w_dn; const float* w_in; const float* conv_w; const float* w_out; const float* kv_norm; const float* w_kv; const float* w_q; const float* w_o;
    float* out; unsigned char* ws; int ph_lo, ph_hi;
};

__device__ __forceinline__ void transpose_item(const float* W, int ldw, int srccol0, int k0, const float* gain, float scale, bf16_t* WT, int K, int dstrow0, LAS float* scr, int lane) {
#pragma unroll 8
    for (int i = 0; i < 32; ++i) { const int kk = 2 * i + (lane >> 5); float v = W[(size_t)(k0 + kk) * ldw + srccol0 + (lane & 31)];
        const float gk = gain ? gain[k0 + kk] * scale : scale; scr[kk * 33 + (lane & 31)] = v * gk; }
    asm volatile("s_waitcnt lgkmcnt(0)" ::: "memory");
    const int c = lane & 7;
#pragma unroll
    for (int j = 0; j < 4; ++j) { const int n = (lane >> 3) + 8 * j; const LAS float* s = scr + (8 * c) * 33 + n;
        u32x4 o; o.x = pk2(s[0 * 33], s[1 * 33]); o.y = pk2(s[2 * 33], s[3 * 33]); o.z = pk2(s[4 * 33], s[5 * 33]); o.w = pk2(s[6 * 33], s[7 * 33]);
        *(u32x4*)(WT + (size_t)(dstrow0 + n) * K + k0 + 8 * c) = o; }
    asm volatile("s_waitcnt lgkmcnt(0)" ::: "memory");
}

template <int MODE>
__device__ __forceinline__ void row_pass(const float* base, const float* y, const float* g, float* hout, bf16_t* xn, int gw, int NGW, int lane) {
    for (int m = gw; m < M; m += NGW) {
        f32x4 v[4];
        if (MODE == 0) {
#pragma unroll
            for (int j = 0; j < 4; ++j) v[j] = ((const f32x4*)(base + (size_t)m * D))[64 * j + lane];
        } else {
            f32x4 yy[4]; float s = 0.f;
#pragma unroll
            for (int j = 0; j < 4; ++j) { yy[j] = ((const f32x4*)(y + (size_t)m * D))[64 * j + lane]; s += (yy[j].x * yy[j].x + yy[j].y * yy[j].y) + (yy[j].z * yy[j].z + yy[j].w * yy[j].w); }
            const float rs = 1.0f / sqrtf(wave_sum(s) * (1.0f / D) + RMS_EPS);
#pragma unroll
            for (int j = 0; j < 4; ++j) { const f32x4 b = ((const f32x4*)(base + (size_t)m * D))[64 * j + lane]; const f32x4 gg = ((const f32x4*)g)[64 * j + lane];
                v[j] = b + yy[j] * rs * gg; ((f32x4*)(hout + (size_t)m * D))[64 * j + lane] = v[j]; }
        }
        if (MODE != 2) {
            float s = 0.f;
#pragma unroll
            for (int j = 0; j < 4; ++j) s += (v[j].x * v[j].x + v[j].y * v[j].y) + (v[j].z * v[j].z + v[j].w * v[j].w);
            const float rs = 1.0f / sqrtf(wave_sum(s) * (1.0f / D) + RMS_EPS);
#pragma unroll
            for (int j = 0; j < 4; ++j) { u32x2 o; o.x = pk2(v[j].x * rs, v[j].y * rs); o.y = pk2(v[j].z * rs, v[j].w * rs); ((u32x2*)(xn + (size_t)m * D))[64 * j + lane] = o; }
        }
    }
}

__device__ __forceinline__ int crow(int r, int hi) { return (r & 3) + 8 * (r >> 2) + 4 * hi; }
__device__ __forceinline__ unsigned cvtpk(float lo, float hi) { typedef __bf16 bf2 __attribute__((ext_vector_type(2))); f32x2 v = {lo, hi}; bf2 b = __builtin_convertvector(v, bf2); return __builtin_bit_cast(unsigned, b); }
typedef short v4i16_t __attribute__((ext_vector_type(4)));
__device__ __forceinline__ s16x4 vtr(const LAS unsigned char* p) { return __builtin_bit_cast(s16x4, __builtin_amdgcn_ds_read_tr16_b64_v4i16((LAS v4i16_t*)p)); }

__device__ __forceinline__ void attn_wave(const bf16_t* Qb, const bf16_t* Kb, const bf16_t* Vb, bf16_t* Ob, float* lse, int rowbase, int colbase, int lsecol,
                                          int dil, int r, int P0, LAS unsigned char* wl, int lane) {
    const int r32 = lane & 31, hi = lane >> 5;
    const float NEG = -1e30f;
    bf16x8 qf[4];
    { const bf16_t* qrow = Qb + (size_t)(rowbase + r + dil * (P0 + r32)) * NQ + colbase + hi * 8;
#pragma unroll
      for (int s = 0; s < 4; ++s) qf[s] = *(const bf16x8*)(qrow + 16 * s); }
    const int kt0 = (P0 >= 128) ? 0 : (4 - (P0 >> 5));
    f32x16 st[5];
#pragma unroll
    for (int kt = 0; kt < 5; ++kt) {
        if (kt >= kt0) {
            const bf16_t* krow = Kb + (size_t)(rowbase + r + dil * (P0 - 128 + 32 * kt + r32)) * NQ + colbase + hi * 8;
            bf16x8 kf[4];
#pragma unroll
            for (int s = 0; s < 4; ++s) kf[s] = *(const bf16x8*)(krow + 16 * s);
            f32x16 a = {};
#pragma unroll
            for (int s = 0; s < 4; ++s) a = __builtin_amdgcn_mfma_f32_32x32x16_bf16(kf[s], qf[s], a, 0, 0, 0);
            st[kt] = a;
        } else {
#pragma unroll
            for (int i = 0; i < 16; ++i) st[kt][i] = NEG;
        }
    }
#pragma unroll
    for (int i = 0; i < 16; ++i) { const int kl = crow(i, hi); if (kl < r32) st[0][i] = NEG; if (kl > r32) st[4][i] = NEG; }
    float mx = NEG;
#pragma unroll
    for (int kt = 0; kt < 5; ++kt)
#pragma unroll
        for (int i = 0; i < 16; ++i) mx = fmaxf(mx, st[kt][i]);
    mx = fmaxf(mx, __shfl_xor(mx, 32));
    float l = 0.f;
#pragma unroll
    for (int kt = 0; kt < 5; ++kt)
#pragma unroll
        for (int i = 0; i < 16; ++i) { const float p = __builtin_amdgcn_exp2f(st[kt][i] - mx); st[kt][i] = p; l += p; }
    l += __shfl_xor(l, 32);
    f32x16 o[2]; o[0] = f32x16{}; o[1] = f32x16{};
    const int vrow = lane >> 1, vhalf = lane & 1;
    const LAS unsigned char* trb = wl + (4 * hi + ((lane & 15) >> 2)) * 64 + ((lane >> 4) & 1) * 32 + (lane & 3) * 8;
#pragma unroll
    for (int kt = 0; kt < 5; ++kt) {
        if (kt >= kt0) {
            const bf16_t* vsrc = Vb + (size_t)(rowbase + r + dil * (P0 - 128 + 32 * kt + vrow)) * NQ + colbase + vhalf * 32;
            const u32x4 v0 = ((const u32x4*)vsrc)[0], v1 = ((const u32x4*)vsrc)[1], v2 = ((const u32x4*)vsrc)[2], v3 = ((const u32x4*)vsrc)[3];
            LAS u32x4* vd = (LAS u32x4*)(wl + vhalf * 2048 + vrow * 64);
            vd[0] = v0; vd[1] = v1; vd[2] = v2; vd[3] = v3;
#pragma unroll
            for (int s = 0; s < 2; ++s) {
                u32x4 pw; pw.x = cvtpk(st[kt][8 * s + 0], st[kt][8 * s + 1]); pw.y = cvtpk(st[kt][8 * s + 2], st[kt][8 * s + 3]);
                pw.z = cvtpk(st[kt][8 * s + 4], st[kt][8 * s + 5]); pw.w = cvtpk(st[kt][8 * s + 6], st[kt][8 * s + 7]);
                const bf16x8 pa = __builtin_bit_cast(bf16x8, pw);
#pragma unroll
                for (int db = 0; db < 2; ++db) {
                    const s16x4 lo = vtr(trb + db * 2048 + s * 1024), hh = vtr(trb + db * 2048 + s * 1024 + 512);
                    const bf16x8 vf = (bf16x8){lo[0], lo[1], lo[2], lo[3], hh[0], hh[1], hh[2], hh[3]};
                    o[db] = __builtin_amdgcn_mfma_f32_32x32x16_bf16(pa, vf, o[db], 0, 0, 0);
                }
            }
        }
    }
    LAS float* sl = (LAS float*)(wl + 4096);
    if (hi == 0) { sl[r32] = __builtin_amdgcn_rcpf(l);
        lse[(size_t)(rowbase + r + dil * (P0 + r32)) * 48 + lsecol] = mx + __builtin_amdgcn_logf(l); }
#pragma unroll
    for (int i = 0; i < 16; ++i) { const int q = crow(i, hi); const float rl = sl[q];
        bf16_t* op = Ob + (size_t)(rowbase + r + dil * (P0 + q)) * NQ + colbase + r32;
        op[0] = (bf16_t)f2bf(o[0][i] * rl); op[32] = (bf16_t)f2bf(o[1][i] * rl); }
}

constexpr int N_PHASES = 19;
__global__ void __launch_bounds__(NWAVES * 64, 2) yoco_fwd(Args a_) {
    extern __shared__ __attribute__((aligned(16))) unsigned char lds_raw[];
    {
        LAS unsigned char* lds0 = (LAS unsigned char*)lds_raw;
        for (int u = threadIdx.x; u < (LDS_BYTES - RING_BYTES) / 4; u += NWAVES * 64) ((LAS unsigned*)(lds0 + RING_BYTES))[u] = 0u;
        __syncthreads();
        if (!MK_PER_PHASE) (void)xcd_barrier_post((unsigned*)(a_.ws + WS_CTL) + 1024, (volatile LAS unsigned*)(lds0 + MISC_OFF) + 8);
    }
    const int ph_hi = a_.ph_hi;
    for (int ph = a_.ph_lo; ph < ph_hi; ++ph) {
        Args a = a_;
        unsigned char* ws = a.ws; asm volatile("" : "+s"(ws));
        int tid = threadIdx.x; asm volatile("" : "+v"(tid));
        int G = gridDim.x, bx = blockIdx.x; asm volatile("" : "+s"(G), "+s"(bx));
        LAS unsigned char* lds = (LAS unsigned char*)lds_raw;
        const int lane = tid & 63, wave = __builtin_amdgcn_readfirstlane(tid >> 6);
        const int vcu = (G % 8 == 0) ? (bx % 8) * (G / 8) + bx / 8 : bx;
        const int gw = vcu * NWAVES + wave, NGW = G * NWAVES;
        float* rope = (float*)(ws + WS_ROPE);
        bf16_t* XN = (bf16_t*)(ws + WS_XN);
        float* Y = (float*)(ws + WS_Y);
        bf16_t* ACT = (bf16_t*)(ws + WS_ACT);
        bf16_t* Ubuf = (bf16_t*)(ws + WS_ACT);
        bf16_t* Bbuf = (bf16_t*)(ws + WS_ACT + 32 * MiB);
        float* LSE = (float*)(ws + WS_LSE);
        const int layer = ph >= 8 ? 1 : 0;
        const int half = (ph >= 11 && ph <= 13) ? 1 : 0;

        if (EN_P0 && ph == 0) {
            LAS float* scr = (LAS float*)(lds + wave * 16384);
            constexpr int I_IN = 16 * 96, I_OUT = 16 * 32, I_GU = 16 * 176, I_DN = 44 * 32, I_KVQ = 16 * 288, I_O = 16 * 32;
            constexpr int NITEMS = I_IN + I_OUT + 2 * I_GU + 2 * I_DN + I_KVQ + I_O;
            for (int it = gw; it < NITEMS; it += NGW) {
                int q = it, kb, n0, srcc, ldw, K = 1024; const float* W; const float* gain = nullptr; float scale = 1.0f; size_t wto;
                if (q < I_IN) { kb = q / 96; n0 = 32 * (q % 96);
                    if (n0 < 1024) srcc = n0; else { const int qq = n0 - 1024, j = qq >> 8, w = qq & 255; srcc = (w < 128 ? 1024 : 2048) + 128 * j + (w & 127); }
                    W = a.w_in; ldw = 3072; gain = a.mix_pre; wto = WS_WIN; }
                else if ((q -= I_IN) < I_OUT) { kb = q / 32; n0 = 32 * (q % 32); srcc = n0; W = a.w_out; ldw = 1024; wto = WS_WOUT; }
                else if ((q -= I_OUT) < 2 * I_GU) { const int ly = q / I_GU; q -= ly * I_GU; kb = q / 176; n0 = 32 * (q % 176); const int j = n0 >> 8, w = n0 & 255;
                    srcc = (w < 128 ? 0 : DFF) + 128 * j + (w & 127); W = a.w_gu + (size_t)ly * D * 2 * DFF; ldw = 2 * DFF; gain = a.ffn_pre + ly * D; wto = ly ? WS_WGU1 : WS_WGU0; }
                else if ((q -= 2 * I_GU) < 2 * I_DN) { const int ly = q / I_DN; q -= ly * I_DN; kb = q / 32; n0 = 32 * (q % 32); srcc = n0;
                    W = a.w_dn + (size_t)ly * DFF * D; ldw = 1024; K = DFF; wto = ly ? WS_WDN1 : WS_WDN0; }
                else if ((q -= 2 * I_DN) < I_KVQ) { kb = q / 288; n0 = 32 * (q % 288); const int part = n0 / NQ, rr = n0 - part * NQ, tile = rr >> 8, w = rr & 255, bj = w >> 7, hl = (w & 127) >> 5;
                    srcc = (4 * tile + hl) * HD + 32 * bj; wto = WS_WKVQ;
                    if (part == 2) { W = a.w_q; ldw = NQ; gain = a.mix_pre + D; scale = QSCALE; } else { W = a.w_kv; ldw = 2 * NQ; srcc += part * NQ; gain = a.kv_norm; } }
                else { q -= I_KVQ; kb = q / 32; n0 = 32 * (q % 32); srcc = n0; W = a.w_o; ldw = 1024; wto = WS_WO; }
                transpose_item(W, ldw, srcc, 64 * kb, gain, scale, (bf16_t*)(ws + wto), K, n0, scr, lane);
            }
            for (int e = gw * 64 + lane; e < M * 32; e += NGW * 64) {
                const int m = e >> 5, i = e & 31;
                const float inv = exp2f((float)i * -0.41524101186092033f);
                const float ang = (float)a.pos[m] * inv;
                const float kq = rintf(ang * 0.63661977236758134308f);
                float yv = fmaf(-kq, 1.57079637050628662109375f, ang);
                yv = fmaf(-kq, -4.37113900018624283e-8f, yv);
                yv = fmaf(-kq, -1.71512449851278e-15f, yv);
                const float y2 = yv * yv;
                const float sn = yv + yv * y2 * (-1.6666654611e-1f + y2 * (8.3321608736e-3f + y2 * -1.9515295891e-4f));
                const float cs = 1.0f - 0.5f * y2 + y2 * y2 * (4.166664568298827e-2f + y2 * (-1.388731625493765e-3f + y2 * 2.443315711809948e-5f));
                const int qd = ((int)kq) & 3;
                const float c = (qd == 0) ? cs : (qd == 1) ? -sn : (qd == 2) ? -cs : sn;
                const float s = (qd == 0) ? sn : (qd == 1) ? cs : (qd == 2) ? -sn : -cs;
                rope[(size_t)m * 64 + i] = c; rope[(size_t)m * 64 + 32 + i] = s;
            }
            row_pass<0>(a.x, nullptr, nullptr, nullptr, XN, gw, NGW, lane);
        } else if (EN_G1 && ph == 1) {
            pg8::Gemm g{XN, (const bf16_t*)(ws + WS_WIN), M, 3072, 1024}; pg8::StaticOrder S; S.init(M, 3072, G, bx);
            pg8::EpiConvIn E{Bbuf, Ubuf};
            pg8::gemm_phase<pg8::EpiConvIn, pg8::StaticOrder, true, true>(lds, g, S, E);
        } else if (EN_CONV && ph == 2) {
            const int c8 = tid & 127, sub = tid >> 7;
            const float* cw = a.conv_w;
            float w0[8], w1[8], w2[8];
#pragma unroll
            for (int i = 0; i < 8; ++i) { w0[i] = cw[c8 * 8 + i]; w1[i] = cw[D + c8 * 8 + i]; w2[i] = cw[2 * D + c8 * 8 + i]; }
            for (int blk = vcu; blk < M / 64; blk += G) {
                const int m0 = blk * 64 + sub * 16; const int t0 = m0 & (SEQ - 1);
                u32x4 um2 = (u32x4){0u, 0u, 0u, 0u}, um1 = (u32x4){0u, 0u, 0u, 0u};
                if (t0 >= 2) { um2 = *(const u32x4*)(Ubuf + (size_t)(m0 - 2) * D + c8 * 8); um1 = *(const u32x4*)(Ubuf + (size_t)(m0 - 1) * D + c8 * 8); }
#pragma unroll 4
                for (int rr = 0; rr < 16; ++rr) {
                    const size_t off = (size_t)(m0 + rr) * D + c8 * 8;
                    const u32x4 u0 = *(const u32x4*)(Ubuf + off); const u32x4 bb = *(const u32x4*)(Bbuf + off);
                    u32x4 o;
#pragma unroll
                    for (int k = 0; k < 4; ++k) {
                        const float cl = w0[2 * k] * bf_lo(um2[k]) + w1[2 * k] * bf_lo(um1[k]) + w2[2 * k] * bf_lo(u0[k]);
                        const float ch = w0[2 * k + 1] * bf_hi(um2[k]) + w1[2 * k + 1] * bf_hi(um1[k]) + w2[2 * k + 1] * bf_hi(u0[k]);
                        o[k] = pk2(cl * bf_lo(bb[k]), ch * bf_hi(bb[k]));
                    }
                    *(u32x4*)(XN + off) = o;
                    um2 = um1; um1 = u0;
                }
            }
        } else if (EN_GF32 && (ph == 3 || ph == 14 || ph == 6 || ph == 17)) {
            const bool dn = (ph == 6 || ph == 17);
            const bf16_t* A = dn ? ACT : XN;
            const size_t wo = (ph == 3) ? WS_WOUT : (ph == 14) ? WS_WO : (ph == 6) ? WS_WDN0 : WS_WDN1;
            pg8::Gemm g{A, (const bf16_t*)(ws + wo), M, 1024, dn ? DFF : 1024}; pg8::StaticOrder S; S.init(M, 1024, G, bx);
            pg8::EpiF32 E{Y, D};
            pg8::gemm_phase<pg8::EpiF32, pg8::StaticOrder, false, true>(lds, g, S, E);
        } else if (EN_ROW && (ph == 4 || ph == 15 || ph == 7)) {
            const float* base = (ph == 4) ? a.x : a.out;
            const float* gain = (ph == 4) ? a.mix_post : (ph == 15) ? a.mix_post + D : a.ffn_post;
            row_pass<1>(base, Y, gain, a.out, XN, gw, NGW, lane);
        } else if (EN_ROW && ph == 18) {
            row_pass<2>(a.out, Y, a.ffn_post + D, a.out, nullptr, gw, NGW, lane);
        } else if (EN_UP && (ph == 5 || ph == 16)) {
            pg8::Gemm g{XN, (const bf16_t*)(ws + (layer ? WS_WGU1 : WS_WGU0)), M, 2 * DFF, 1024}; pg8::StaticOrder S; S.init(M, 2 * DFF, G, bx);
            pg8::EpiSwiGLU E{ACT};
            pg8::gemm_phase<pg8::EpiSwiGLU, pg8::StaticOrder, true, true>(lds, g, S, E);
        } else if (EN_KVQ && (ph == 8 || ph == 11)) {
            pg8::Gemm g{XN + (size_t)half * MH * D, (const bf16_t*)(ws + WS_WKVQ), MH, 3 * NQ, 1024}; pg8::StaticOrder S; S.init(MH, 3 * NQ, G, bx);
            pg8::EpiKVQ E{(bf16_t*)(ws + WS_K), (bf16_t*)(ws + WS_V), (bf16_t*)(ws + WS_Q), rope + (size_t)half * MH * 64};
            pg8::gemm_phase<pg8::EpiKVQ, pg8::StaticOrder, true, true>(lds, g, S, E);
        } else if (EN_ATT && (ph == 9 || ph == 12)) {
            bf16_t* Kb = (bf16_t*)(ws + WS_K); bf16_t* Vb = (bf16_t*)(ws + WS_V); bf16_t* Qb = (bf16_t*)(ws + WS_Q);
            constexpr int NUNITS = 2 * 3 * NH * 16;
            LAS unsigned char* wl = lds + wave * 8192;
            for (int un = vcu; un < NUNITS; un += G) {
                const int c16 = un & 15, h = (un >> 4) & 15, gb = un >> 8, g = gb % 3, bl = gb / 3;
                const int dil = (g == 0) ? 1 : (g == 1 ? 4 : 16);
                const int Lq = SEQ / dil / 256;
                const int r = c16 / Lq, cc = c16 - r * Lq;
                attn_wave(Qb, Kb, Vb, Qb, LSE + (size_t)half * MH * 48, bl * SEQ, g * 1024 + h * HD, g * NH + h, dil, r, cc * 256 + wave * 32, wl, lane);
            }
        } else if (EN_MIX && (ph == 10 || ph == 13)) {
            const bf16_t* Qb = (const bf16_t*)(ws + WS_Q);
            for (int mm = gw; mm < MH; mm += NGW) {
                const int m = half * MH + mm; const int h = lane >> 2, dp = (lane & 3) * 16;
                const float l0 = LSE[(size_t)m * 48 + h], l1 = LSE[(size_t)m * 48 + 16 + h], l2 = LSE[(size_t)m * 48 + 32 + h];
                const float mx = fmaxf(l0, fmaxf(l1, l2));
                float w0 = __builtin_amdgcn_exp2f(l0 - mx), w1 = __builtin_amdgcn_exp2f(l1 - mx), w2 = __builtin_amdgcn_exp2f(l2 - mx);
                const float inv = 1.0f / (w0 + w1 + w2); w0 *= inv; w1 *= inv; w2 *= inv;
                const bf16_t* op = Qb + (size_t)mm * NQ + h * HD + dp;
#pragma unroll
                for (int q = 0; q < 2; ++q) {
                    const u32x4 a0 = *(const u32x4*)(op + 8 * q), a1 = *(const u32x4*)(op + 1024 + 8 * q), a2 = *(const u32x4*)(op + 2048 + 8 * q);
                    u32x4 o;
#pragma unroll
                    for (int k = 0; k < 4; ++k) o[k] = pk2(w0 * bf_lo(a0[k]) + w1 * bf_lo(a1[k]) + w2 * bf_lo(a2[k]), w0 * bf_hi(a0[k]) + w1 * bf_hi(a1[k]) + w2 * bf_hi(a2[k]));
                    *(u32x4*)(XN + (size_t)m * D + h * HD + dp + 8 * q) = o;
                }
            }
        }
        if (ph + 1 < ph_hi) { XcdBarrier bar; bar.bar = (unsigned*)(ws + WS_CTL) + 1024; bar.x = xb_xcc_id(); bar.st = (volatile LAS unsigned*)(lds + MISC_OFF) + 8; xcd_barrier(bar); }
    }
}

extern "C" void kernel_launch(void* const* d_in, const int* in_sizes, int n_in, void* d_out, int out_size, void* d_ws, size_t ws_size, hipStream_t stream) {
    static int grid = 0;
    if (grid == 0) {
        if (n_in != 15 || out_size != M * D || ws_size < WS_END) { fprintf(stderr, "kernel_launch: unexpected shapes (n_in %d, out %d, ws %zu)\n", n_in, out_size, ws_size); grid = -1; return; }
        int dev = 0, cus = 0;
        if (hipGetDevice(&dev) != hipSuccess || hipDeviceGetAttribute(&cus, hipDeviceAttributeMultiprocessorCount, dev) != hipSuccess) { grid = -1; return; }
        if (hipFuncSetAttribute((const void*)yoco_fwd, hipFuncAttributeMaxDynamicSharedMemorySize, LDS_BYTES) != hipSuccess) { fprintf(stderr, "kernel_launch: hipFuncSetAttribute failed\n"); grid = -1; return; }
        int per_cu = 0;
        (void)hipOccupancyMaxActiveBlocksPerMultiprocessor(&per_cu, (const void*)yoco_fwd, NWAVES * 64, LDS_BYTES);
        (void)hipGetLastError();
        grid = cus;
    }
    if (grid < 0) return;
    (void)hipMemsetAsync((char*)d_ws + WS_CTL, 0, CTL_ZERO_BYTES, stream);
    Args a{};
    a.x = (const float*)d_in[0]; a.pos = (const int*)d_in[1]; a.mix_pre = (const float*)d_in[2]; a.mix_post = (const float*)d_in[3];
    a.ffn_pre = (const float*)d_in[4]; a.ffn_post = (const float*)d_in[5]; a.w_gu = (const float*)d_in[6]; a.w_dn = (const float*)d_in[7];
    a.w_in = (const float*)d_in[8]; a.conv_w = (const float*)d_in[9]; a.w_out = (const float*)d_in[10]; a.kv_norm = (const float*)d_in[11];
    a.w_kv = (const float*)d_in[12]; a.w_q = (const float*)d_in[13]; a.w_o = (const float*)d_in[14];
    a.out = (float*)d_out; a.ws = (unsigned char*)d_ws;
#if MK_PER_PHASE
    for (int p = 0; p < N_PHASES; ++p) { a.ph_lo = p; a.ph_hi = p + 1; hipLaunchKernelGGL(yoco_fwd, dim3(grid), dim3(NWAVES * 64), LDS_BYTES, stream, a); }
#else
    a.ph_lo = 0; a.ph_hi = N_PHASES;
    hipLaunchKernelGGL(yoco_fwd, dim3(grid), dim3(NWAVES * 64), LDS_BYTES, stream, a);
#endif
}
```

```cpp
#include <hip/hip_runtime.h>
#include <cstdio>
#include <cstdint>

#ifndef MK_PER_PHASE
#define MK_PER_PHASE 0
#endif

#ifndef EN_ALL
#define EN_ALL 1
#endif
#ifndef EN_P0
#define EN_P0 EN_ALL
#endif
#ifndef EN_G1
#define EN_G1 EN_ALL
#endif
#ifndef EN_CONV
#define EN_CONV EN_ALL
#endif
#ifndef EN_GF32
#define EN_GF32 EN_ALL
#endif
#ifndef EN_ROW
#define EN_ROW EN_ALL
#endif
#ifndef EN_UP
#define EN_UP EN_ALL
#endif
#ifndef EN_KVQ
#define EN_KVQ EN_ALL
#endif
#ifndef EN_ATT
#define EN_ATT EN_ALL
#endif
#ifndef EN_MIX
#define EN_MIX EN_ALL
#endif
#define LAS __attribute__((address_space(3)))
#define GAS __attribute__((address_space(1)))
typedef unsigned short bf16_t;
typedef short bf16x8 __attribute__((ext_vector_type(8)));
typedef short s16x4 __attribute__((ext_vector_type(4)));
typedef float f32x4 __attribute__((ext_vector_type(4)));
typedef float f32x2 __attribute__((ext_vector_type(2)));
typedef float f32x16 __attribute__((ext_vector_type(16)));
typedef unsigned u32x4 __attribute__((ext_vector_type(4)));
typedef unsigned u32x2 __attribute__((ext_vector_type(2)));

constexpr int BATCH = 4, SEQ = 4096, D = 1024, M = BATCH * SEQ, DFF = 2816, NQ = 3072, NH = 16, HD = 64;
constexpr int MH = M / 2;
constexpr float RMS_EPS = 1e-6f;
constexpr float QSCALE = 0.125f * 1.4426950408889634f;

namespace pg8 {
constexpr int BM = 256, BK = 64, HALF = 128, HTB = HALF * BK * 2, STAGE_BYTES = 8 * HTB, NXCD = 8, WGM = 8;
__host__ __device__ __forceinline__ int lds_byte(int r, int c) { const int st = (r >> 4) * 2 + (c >> 5), rr = r & 15, cc = c & 31, ob = rr * 64 + cc * 2; return st * 1024 + (ob ^ (((ob >> 9) & 1) << 5)); }
__host__ __device__ __forceinline__ void stage_rc(int b, int& R, int& C) { const int st = b / 1024, sb = b % 1024, swz = sb ^ (((sb >> 9) & 1) << 5); R = (st >> 1) * 16 + swz / 64; C = (st & 1) * 32 + (swz % 64) / 2; }
__host__ __device__ __forceinline__ int perm32(int rho) { const int n = rho >> 4, i = rho & 15; return 8 * (i >> 2) + 4 * n + (i & 3); }

struct Unit { int pm, pn; };
struct Gemm { const bf16_t* A; const bf16_t* Bt; int M, N, K; };

struct StaticOrder {
    int nM, nN, nwg, G, c;
    __host__ __device__ void init(int M_, int N_, int G_, int c_) { nM = M_ / BM; nN = N_ / BM; nwg = nM * nN; G = G_; c = c_; }
    __host__ __device__ bool next(int i, Unit& u) const {
        const long L = (long)i * G + c; if (L >= nwg) return false;
        int wgid = (int)L; { const int q = nwg / NXCD, r = nwg % NXCD, xcd = wgid % NXCD, off = wgid / NXCD; wgid = (xcd < r ? xcd * (q + 1) : r * (q + 1) + (xcd - r) * q) + off; }
        const int nig = WGM * nN, gid = wgid / nig, fm = gid * WGM, gsz = (nM - fm) < WGM ? (nM - fm) : WGM;
        u.pm = fm + ((wgid % nig) % gsz); u.pn = (wgid % nig) / gsz; return true;
    }
    __device__ __forceinline__ void a_ready(const Unit&) const {}
    __device__ __forceinline__ void done(const Unit&) const {}
};

__device__ __forceinline__ unsigned cvt_pk_bf16(float lo, float hi) { unsigned r; asm volatile("v_cvt_pk_bf16_f32 %0, %1, %2" : "=v"(r) : "v"(lo), "v"(hi)); return r; }

struct EpiF32 {
    static constexpr bool PERM = false, AFTER_DRAIN = false;
    float* C; int ldc;
    __device__ __forceinline__ void operator()(const f32x4 (&acc)[2][2][4][2], const Unit& u, int wr, int wc, int fr, int fq) const {
        const int row0 = u.pm * BM + wr * 64 + fr, col0 = u.pn * BM + wc * 32 + 4 * fq;
#pragma unroll
        for (int ai = 0; ai < 2; ++ai)
#pragma unroll
            for (int m = 0; m < 4; ++m) { float* rowp = C + (size_t)(row0 + ai * HALF + m * 16) * ldc + col0;
#pragma unroll
                for (int bj = 0; bj < 2; ++bj)
#pragma unroll
                    for (int n = 0; n < 2; ++n) *(f32x4*)(rowp + bj * HALF + n * 16) = acc[ai][bj][m][n]; }
    }
};
struct EpiConvIn {
    static constexpr bool PERM = true, AFTER_DRAIN = false;
    bf16_t* Bg; bf16_t* U;
    __device__ __forceinline__ void operator()(const f32x4 (&acc)[2][2][4][2], const Unit& u, int wr, int wc, int fr, int fq) const {
        const int row0 = u.pm * BM + wr * 64 + fr;
        if (u.pn < 4) {
            const int col0 = u.pn * BM + wc * 32 + 8 * fq;
#pragma unroll
            for (int ai = 0; ai < 2; ++ai)
#pragma unroll
                for (int m = 0; m < 4; ++m) { bf16_t* rowp = Bg + (size_t)(row0 + ai * HALF + m * 16) * D + col0;
#pragma unroll
                    for (int bj = 0; bj < 2; ++bj) { const f32x4 v0 = acc[ai][bj][m][0], v1 = acc[ai][bj][m][1];
                        u32x4 w; w.x = cvt_pk_bf16(v0[0], v0[1]); w.y = cvt_pk_bf16(v0[2], v0[3]); w.z = cvt_pk_bf16(v1[0], v1[1]); w.w = cvt_pk_bf16(v1[2], v1[3]);
                        *(u32x4*)(rowp + bj * HALF) = w; } }
        } else {
            const int col0 = (u.pn - 4) * HALF + wc * 32 + 8 * fq;
#pragma unroll
            for (int ai = 0; ai < 2; ++ai)
#pragma unroll
                for (int m = 0; m < 4; ++m) { bf16_t* rowp = U + (size_t)(row0 + ai * HALF + m * 16) * D + col0;
                    const f32x4 v0 = acc[ai][0][m][0] * acc[ai][1][m][0], v1 = acc[ai][0][m][1] * acc[ai][1][m][1];
                    u32x4 w; w.x = cvt_pk_bf16(v0[0], v0[1]); w.y = cvt_pk_bf16(v0[2], v0[3]); w.z = cvt_pk_bf16(v1[0], v1[1]); w.w = cvt_pk_bf16(v1[2], v1[3]);
                    *(u32x4*)rowp = w; }
        }
    }
};
struct EpiSwiGLU {
    static constexpr bool PERM = true, AFTER_DRAIN = false;
    bf16_t* Act;
    __device__ __forceinline__ static f32x4 silu_mul(f32x4 g, f32x4 u) {
        f32x4 o;
#pragma unroll
        for (int i = 0; i < 4; ++i) { const float e = __builtin_amdgcn_exp2f(g[i] * -1.4426950408889634f); o[i] = g[i] * __builtin_amdgcn_rcpf(1.0f + e) * u[i]; }
        return o;
    }
    __device__ __forceinline__ void operator()(const f32x4 (&acc)[2][2][4][2], const Unit& u, int wr, int wc, int fr, int fq) const {
        const int row0 = u.pm * BM + wr * 64 + fr, col0 = u.pn * HALF + wc * 32 + 8 * fq;
#pragma unroll
        for (int ai = 0; ai < 2; ++ai)
#pragma unroll
            for (int m = 0; m < 4; ++m) { bf16_t* rowp = Act + (size_t)(row0 + ai * HALF + m * 16) * DFF + col0;
                const f32x4 v0 = silu_mul(acc[ai][0][m][0], acc[ai][1][m][0]), v1 = silu_mul(acc[ai][0][m][1], acc[ai][1][m][1]);
                u32x4 w; w.x = cvt_pk_bf16(v0[0], v0[1]); w.y = cvt_pk_bf16(v0[2], v0[3]); w.z = cvt_pk_bf16(v1[0], v1[1]); w.w = cvt_pk_bf16(v1[2], v1[3]);
                *(u32x4*)rowp = w; }
    }
};
struct EpiKVQ {
    static constexpr bool PERM = true, AFTER_DRAIN = false;
    bf16_t* Kb; int g; const float* rope;
    __device__ __forceinline__ void operator()(const f32x4 (&acc)[2][2][4][2], const Unit& u, int wr, int wc, int fr, int fq) const {
        const int part = u.pn >> 2, tile = u.pn & 3;
        const int row0 = u.pm * BM + wr * 64 + fr, col0 = (4 * tile + wc) * HD + 8 * fq;
        bf16_t* base = Kb + (size_t)(part + (part == 2 ? g : 0)) * ((size_t)M * D);
#pragma unroll
        for (int ai = 0; ai < 2; ++ai)
#pragma unroll
            for (int m = 0; m < 4; ++m) { const int row = row0 + ai * HALF + m * 16; bf16_t* rowp = base + (size_t)row * D + col0;
                f32x4 a0 = acc[ai][0][m][0], a1 = acc[ai][0][m][1], b0 = acc[ai][1][m][0], b1 = acc[ai][1][m][1];
                if (part != 1) { const float* rp = rope + (size_t)row * 64 + 8 * fq;
                    const f32x4 c0 = *(const f32x4*)rp, c1 = *(const f32x4*)(rp + 4), s0 = *(const f32x4*)(rp + 32), s1 = *(const f32x4*)(rp + 36);
                    const f32x4 x0 = a0 * c0 - b0 * s0, x1 = a1 * c1 - b1 * s1, y0 = b0 * c0 + a0 * s0, y1 = b1 * c1 + a1 * s1;
                    a0 = x0; a1 = x1; b0 = y0; b1 = y1; }
                u32x4 w; w.x = cvt_pk_bf16(a0[0], a0[1]); w.y = cvt_pk_bf16(a0[2], a0[3]); w.z = cvt_pk_bf16(a1[0], a1[1]); w.w = cvt_pk_bf16(a1[2], a1[3]);
                *(u32x4*)rowp = w;
                w.x = cvt_pk_bf16(b0[0], b0[1]); w.y = cvt_pk_bf16(b0[2], b0[3]); w.z = cvt_pk_bf16(b1[0], b1[1]); w.w = cvt_pk_bf16(b1[2], b1[3]);
                *(u32x4*)(rowp + 32) = w; }
    }
};

template <class Epi, class Sched, bool ALIGN_EPI = false, bool SP2 = false>
__device__ __forceinline__ void gemm_phase(LAS unsigned char* lds, const Gemm g, const Sched& S, const Epi& E, const int tid) {
    const int wid = __builtin_amdgcn_readfirstlane(tid >> 6), lane = tid & 63, wr = wid >> 2, wc = wid & 3, fr = lane & 15, fq = lane >> 4;
    const int K = g.K, nt = K / BK;
    unsigned voffA[2], voffB[2];
#pragma unroll
    for (int i = 0; i < 2; ++i) { int R, C; stage_rc(tid * 16 + i * 8192, R, C); const int Rb = Epi::PERM ? ((R & ~31) + perm32(R & 31)) : R;
        voffA[i] = (unsigned)(R * K + C) * 2u; voffB[i] = (unsigned)(Rb * K + C) * 2u; }
    const size_t kstep = (size_t)(BK * 2);
    const size_t hstep = (size_t)HALF * K * 2;
    const size_t tstep = 2 * hstep;
    const unsigned ldsw = (unsigned)wid * 1024u;
    const int aoff = lds_byte(wr * 64 + fr, fq * 8), boff = lds_byte(wc * 32 + fr, fq * 8);
#define PG8_SA(b, h) (((b) * 2 + (h)) * HTB)
#define PG8_SB(b, h) ((4 + (b) * 2 + (h)) * HTB)
#define PG8_STAGE(bufoff, gbase, voff) do { _Pragma("unroll") for (int _i = 0; _i < 2; ++_i) \
        __builtin_amdgcn_global_load_lds((const unsigned*)((const char*)(gbase) + (voff)[_i]), (LAS unsigned*)(lds + (bufoff) + ldsw + _i * 8192), 16, 0, 0); } while (0)
#define PG8_LDA(dst, b, h) do { _Pragma("unroll") for (int m = 0; m < 4; ++m) _Pragma("unroll") for (int k = 0; k < 2; ++k) dst[m][k] = *(const LAS bf16x8*)(lds + PG8_SA(b, h) + aoff + m * 2048 + k * 1024); } while (0)
#define PG8_LDB(dst, b, h) do { _Pragma("unroll") for (int n = 0; n < 2; ++n) _Pragma("unroll") for (int k = 0; k < 2; ++k) dst[n][k] = *(const LAS bf16x8*)(lds + PG8_SB(b, h) + boff + n * 2048 + k * 1024); } while (0)
#define PG8_MMA(ai, bj, At, Bt) do { __builtin_amdgcn_s_setprio(1); _Pragma("unroll") for (int m = 0; m < 4; ++m) _Pragma("unroll") for (int n = 0; n < 2; ++n) _Pragma("unroll") for (int k = 0; k < 2; ++k) \
        acc[ai][bj][m][n] = __builtin_amdgcn_mfma_f32_16x16x32_bf16(Bt[n][k], At[m][k], acc[ai][bj][m][n], 0, 0, 0); __builtin_amdgcn_s_setprio(0); } while (0)
#define PG8_WAIT_V(n) asm volatile("s_waitcnt vmcnt(" #n ")" ::: "memory")
#define PG8_WAIT_L(n) asm volatile("s_waitcnt lgkmcnt(" #n ")" ::: "memory")
#define PG8_BAR __builtin_amdgcn_s_barrier()
#define PG8_SCHED __builtin_amdgcn_sched_barrier(0)
    Unit cur, nxt; int ui = 0;
    if (!S.next(0, cur)) return;
    f32x4 acc[2][2][4][2];
#pragma unroll
    for (int a = 0; a < 2; ++a)
#pragma unroll
        for (int b = 0; b < 2; ++b)
#pragma unroll
            for (int m = 0; m < 4; ++m)
#pragma unroll
                for (int n = 0; n < 2; ++n) acc[a][b][m][n] = (f32x4){0.f, 0.f, 0.f, 0.f};
    bf16x8 At[4][2], B0[2][2], B1[2][2];
    const char* cA = (const char*)g.A + (size_t)cur.pm * tstep; const char* cB = (const char*)g.Bt + (size_t)cur.pn * tstep;
    S.a_ready(cur);
    if constexpr (SP2) {
        PG8_STAGE(PG8_SB(0, 0), cB, voffB); PG8_STAGE(PG8_SB(0, 1), cB + hstep, voffB); PG8_STAGE(PG8_SA(0, 0), cA, voffA); PG8_STAGE(PG8_SA(0, 1), cA + hstep, voffA);
        if (wr == 1) PG8_BAR;
        PG8_WAIT_V(2); PG8_BAR;
        PG8_STAGE(PG8_SB(1, 0), cB + kstep, voffB); PG8_STAGE(PG8_SA(1, 0), cA + kstep, voffA); PG8_STAGE(PG8_SB(1, 1), cB + hstep + kstep, voffB);
        PG8_WAIT_V(6); PG8_BAR;
    } else {
        PG8_STAGE(PG8_SB(0, 0), cB, voffB); PG8_STAGE(PG8_SA(0, 0), cA, voffA); PG8_STAGE(PG8_SB(0, 1), cB + hstep, voffB); PG8_STAGE(PG8_SA(0, 1), cA + hstep, voffA);
        if (wr == 1) PG8_BAR;
        PG8_WAIT_V(4); PG8_BAR;
        PG8_STAGE(PG8_SB(1, 0), cB + kstep, voffB); PG8_STAGE(PG8_SA(1, 0), cA + kstep, voffA); PG8_STAGE(PG8_SB(1, 1), cB + hstep + kstep, voffB);
        PG8_WAIT_V(6); PG8_BAR;
    }
    for (;;) {
        const bool has_next = S.next(ui + 1, nxt);
        const char* nA = has_next ? (const char*)g.A + (size_t)nxt.pm * tstep : cA; const char* nB = has_next ? (const char*)g.Bt + (size_t)nxt.pn * tstep : cB;
        for (int t = 0; t < nt; t += 2) {
            const bool last = (t == nt - 2);
            const char* a1 = cA + (size_t)(t + 1) * kstep;
            const char* a2 = last ? nA : cA + (size_t)(t + 2) * kstep; const char* b2 = last ? nB : cB + (size_t)(t + 2) * kstep;
            const char* a3 = a2 + kstep; const char* b3 = b2 + kstep;
            if (last && has_next) S.a_ready(nxt);
            if constexpr (SP2) {
            PG8_LDB(B0, 0, 0); PG8_LDB(B1, 0, 1); PG8_SCHED; PG8_LDA(At, 0, 0); PG8_STAGE(PG8_SA(1, 1), a1 + hstep, voffA);
            PG8_WAIT_V(8); PG8_WAIT_L(0); PG8_BAR; PG8_MMA(0, 0, At, B0); PG8_MMA(0, 1, At, B1); PG8_BAR; PG8_SCHED;
            PG8_LDA(At, 0, 1); PG8_STAGE(PG8_SB(0, 0), b2, voffB); PG8_STAGE(PG8_SB(0, 1), b2 + hstep, voffB); PG8_STAGE(PG8_SA(0, 0), a2, voffA);
            PG8_WAIT_V(8); PG8_WAIT_L(0); PG8_BAR; PG8_MMA(1, 0, At, B0); PG8_MMA(1, 1, At, B1); PG8_BAR; PG8_SCHED;
            PG8_LDB(B0, 1, 0); PG8_LDB(B1, 1, 1); PG8_SCHED; PG8_LDA(At, 1, 0); PG8_STAGE(PG8_SA(0, 1), a2 + hstep, voffA);
            PG8_WAIT_V(8); PG8_WAIT_L(0); PG8_BAR; PG8_MMA(0, 0, At, B0); PG8_MMA(0, 1, At, B1); PG8_BAR; PG8_SCHED;
            PG8_LDA(At, 1, 1); PG8_STAGE(PG8_SB(1, 0), b3, voffB); PG8_STAGE(PG8_SB(1, 1), b3 + hstep, voffB); PG8_STAGE(PG8_SA(1, 0), a3, voffA);
            PG8_WAIT_V(8); PG8_WAIT_L(0); PG8_BAR; PG8_MMA(1, 0, At, B0); PG8_MMA(1, 1, At, B1); PG8_BAR; PG8_SCHED;
            } else {
            PG8_LDB(B0, 0, 0); PG8_SCHED; PG8_LDA(At, 0, 0); PG8_STAGE(PG8_SA(1, 1), a1 + hstep, voffA);
            PG8_WAIT_L(8); PG8_BAR; PG8_WAIT_L(0); PG8_MMA(0, 0, At, B0); PG8_BAR; PG8_SCHED;
            PG8_LDB(B1, 0, 1); PG8_STAGE(PG8_SB(0, 0), b2, voffB);
            PG8_BAR; PG8_WAIT_L(0); PG8_MMA(0, 1, At, B1); PG8_BAR;
            PG8_LDA(At, 0, 1); PG8_STAGE(PG8_SA(0, 0), a2, voffA);
            PG8_BAR; PG8_WAIT_L(0); PG8_MMA(1, 0, At, B0); PG8_BAR; PG8_SCHED;
            PG8_STAGE(PG8_SB(0, 1), b2 + hstep, voffB);
            PG8_WAIT_V(6); PG8_BAR; PG8_MMA(1, 1, At, B1); PG8_BAR;
            PG8_LDB(B0, 1, 0); PG8_SCHED; PG8_LDA(At, 1, 0); PG8_STAGE(PG8_SA(0, 1), a2 + hstep, voffA);
            PG8_WAIT_L(8); PG8_BAR; PG8_WAIT_L(0); PG8_MMA(0, 0, At, B0); PG8_BAR; PG8_SCHED;
            PG8_LDB(B1, 1, 1); PG8_STAGE(PG8_SB(1, 0), b3, voffB);
            PG8_BAR; PG8_WAIT_L(0); PG8_MMA(0, 1, At, B1); PG8_BAR;
            PG8_LDA(At, 1, 1); PG8_STAGE(PG8_SA(1, 0), a3, voffA);
            PG8_BAR; PG8_WAIT_L(0); PG8_MMA(1, 0, At, B0); PG8_BAR; PG8_SCHED;
            PG8_STAGE(PG8_SB(1, 1), b3 + hstep, voffB);
            PG8_WAIT_V(6); PG8_BAR; PG8_MMA(1, 1, At, B1); PG8_BAR;
            }
        }
        if constexpr (ALIGN_EPI) { if (wr == 0) PG8_BAR; }
        if constexpr (!Epi::AFTER_DRAIN) { E(acc, cur, wr, wc, fr, fq); S.done(cur); }
        if (!has_next) break;
#pragma unroll
        for (int a = 0; a < 2; ++a)
#pragma unroll
            for (int b = 0; b < 2; ++b)
#pragma unroll
                for (int m = 0; m < 4; ++m)
#pragma unroll
                    for (int n = 0; n < 2; ++n) acc[a][b][m][n] = (f32x4){0.f, 0.f, 0.f, 0.f};
        cur = nxt; cA = nA; cB = nB; ++ui;
        if constexpr (ALIGN_EPI) { if (wr == 1) PG8_BAR; }
    }
    PG8_WAIT_V(0);
    if constexpr (!ALIGN_EPI) { if (wr == 0) PG8_BAR; }
    PG8_BAR;
#undef PG8_SA
#undef PG8_SB
#undef PG8_STAGE
#undef PG8_LDA
#undef PG8_LDB
#undef PG8_MMA
#undef PG8_WAIT_V
#undef PG8_WAIT_L
#undef PG8_BAR
#undef PG8_SCHED
}
}

constexpr size_t MiB = 1u << 20;
constexpr size_t WS_CTL = 0, CTL_ZERO_BYTES = 64 * 1024;
constexpr size_t WS_ROPE = 1 * MiB;
constexpr size_t WS_WKVQ = 5 * MiB;
constexpr size_t WS_WO = 23 * MiB;
constexpr size_t WS_WGU1 = 25 * MiB;
constexpr size_t WS_WDN1 = 36 * MiB;
constexpr size_t WS_XN = 36 * MiB + 5632 * 1024;
constexpr size_t WS_WIN = WS_XN + 32 * MiB;
constexpr size_t WS_WOUT = WS_WIN + 6 * MiB;
constexpr size_t WS_WGU0 = WS_WOUT + 2 * MiB;
constexpr size_t WS_WDN0 = WS_WGU0 + 11 * MiB;
constexpr size_t WS_Y = 98 * MiB;
constexpr size_t WS_ACT = 162 * MiB;
constexpr size_t WS_K = 74 * MiB, WS_V = 106 * MiB, WS_QO = 138 * MiB;
constexpr size_t WS_LSE = 250 * MiB;
constexpr size_t WS_END = 253 * MiB;
static_assert(WS_WDN0 + 5632 * 1024 == WS_Y && WS_QO + 96 * MiB <= WS_LSE && WS_ACT + (size_t)M * DFF * 2 <= WS_LSE && WS_K >= WS_XN + 32 * MiB && WS_V - WS_K == 32 * MiB && WS_QO - WS_V == 32 * MiB, "d_ws map");

constexpr int RING_BYTES = 131072, MISC_OFF = RING_BYTES + 320, LDS_BYTES = 147456;
constexpr int NWAVES = 8;

#define XB_TMO      128
#define XB_XCNT(j)  (256  + 64 * (j))
#define XB_XSUB(j)  (1280 + 64 * (j))
#define XB_XGEN(j)  (2304 + 64 * (j))
#define XB_TOP      3328
#define XB_TOPGEN   3392
#define XCD_BAR_WORDS 3456
#define XB_SPIN_CAP (1u << 18)
__device__ __forceinline__ unsigned xb_ld(unsigned* p)              { return __hip_atomic_load(p, __ATOMIC_RELAXED, __HIP_MEMORY_SCOPE_AGENT); }
__device__ __forceinline__ unsigned xb_add(unsigned* p, unsigned v) { return __hip_atomic_fetch_add(p, v, __ATOMIC_RELAXED, __HIP_MEMORY_SCOPE_AGENT); }
__device__ __forceinline__ unsigned xb_xcc_id() { return (unsigned)__builtin_amdgcn_s_getreg((3 << 11) | 20) & 0xFu; }
#define XB_SPIN(cond, bar) do { unsigned _sp = 0; while (cond) { __builtin_amdgcn_s_sleep(1); \
    if ((++_sp & 255u) == 0u) { if (xb_ld(&(bar)[XB_TMO])) break; if (_sp > XB_SPIN_CAP) { atomicAdd(&(bar)[XB_TMO], 1u); break; } } } } while (0)
struct XcdBarrier { unsigned* bar; unsigned x; volatile LAS unsigned* st; };
__device__ __forceinline__ XcdBarrier xcd_barrier_post(unsigned* bar, volatile LAS unsigned* st) {
    XcdBarrier b; b.bar = bar; b.x = xb_xcc_id(); b.st = st;
    if (threadIdx.x == 0) (void)xb_add(&bar[XB_XCNT(b.x)], 1u);
    return b;
}
__device__ __forceinline__ void xcd_barrier_complete(unsigned* bar, unsigned x, unsigned& nloc, unsigned& nx) {
    const unsigned G = gridDim.x * gridDim.y * gridDim.z;
    unsigned sum, cnt, mine, sp = 0u;
    for (;;) {
        sum = 0u; cnt = 0u; mine = 0u;
#pragma unroll 1
        for (unsigned j = 0; j < 16; ++j) { const unsigned c = xb_ld(&bar[XB_XCNT(j)]); sum += c; cnt += (c > 0u) ? 1u : 0u; mine = (j == x) ? c : mine; }
        if (sum == G) break;
        __builtin_amdgcn_s_sleep(1);
        if ((++sp & 255u) == 0u) { if (xb_ld(&bar[XB_TMO])) break; if (sp > XB_SPIN_CAP) { atomicAdd(&bar[XB_TMO], 1u); break; } }
    }
    nloc = mine > 0u ? mine : 1u; nx = cnt > 0u ? cnt : 1u;
}
__device__ __forceinline__ void xcd_barrier(const XcdBarrier& b) {
    asm volatile("s_waitcnt vmcnt(0)" ::: "memory");
    __syncthreads();
    if (threadIdx.x == 0) {
        unsigned* bar = b.bar;
        __builtin_amdgcn_s_waitcnt(0);
        unsigned nloc = b.st[0], nx = b.st[1];
        if (nloc == 0u) { xcd_barrier_complete(bar, b.x, nloc, nx); b.st[0] = nloc; b.st[1] = nx; }
        const unsigned old = xb_add(&bar[XB_XSUB(b.x)], 1u);
        const unsigned gen = old / nloc;
        if (old + 1u == (gen + 1u) * nloc) {
            __builtin_amdgcn_fence(__ATOMIC_RELEASE, "agent");
            asm volatile("s_waitcnt vmcnt(0)" ::: "memory");
            const unsigned og = xb_add(&bar[XB_TOP], 1u);
            const unsigned tg = og / nx;
            if (og + 1u == (tg + 1u) * nx) xb_add(&bar[XB_TOPGEN], 1u);
            else XB_SPIN(xb_ld(&bar[XB_TOPGEN]) == tg, bar);
            __builtin_amdgcn_fence(__ATOMIC_ACQUIRE, "agent");
            xb_add(&bar[XB_XGEN(b.x)], 1u);
            asm volatile("s_waitcnt vmcnt(0)" ::: "memory");
        } else {
            XB_SPIN(xb_ld(&bar[XB_XGEN(b.x)]) == gen, bar);
            __builtin_amdgcn_fence(__ATOMIC_ACQUIRE, "agent");
            asm volatile("s_waitcnt vmcnt(0)" ::: "memory");
        }
    }
    __syncthreads();
}

__device__ __forceinline__ unsigned f2bf(float f) { unsigned u = __builtin_bit_cast(unsigned, f); return (u + 0x7fffu + ((u >> 16) & 1u)) >> 16; }
__device__ __forceinline__ unsigned pk2(float lo, float hi) { return f2bf(lo) | (f2bf(hi) << 16); }
__device__ __forceinline__ float bf_lo(unsigned w) { return __builtin_bit_cast(float, w << 16); }
__device__ __forceinline__ float bf_hi(unsigned w) { return __builtin_bit_cast(float, w & 0xffff0000u); }
__device__ __forceinline__ float wave_sum(float v, int lane) {
#pragma unroll
    for (int o = 1; o < 64; o <<= 1) v += __builtin_bit_cast(float, __builtin_amdgcn_ds_bpermute((lane ^ o) << 2, __builtin_bit_cast(int, v)));
    return v;
}
__device__ __forceinline__ float xhalf_max(float v) { auto r = __builtin_amdgcn_permlane32_swap(__builtin_bit_cast(unsigned, v), __builtin_bit_cast(unsigned, v), false, false); return fmaxf(__builtin_bit_cast(float, r[0]), __builtin_bit_cast(float, r[1])); }
__device__ __forceinline__ float xhalf_sum(float v) { auto r = __builtin_amdgcn_permlane32_swap(__builtin_bit_cast(unsigned, v), __builtin_bit_cast(unsigned, v), false, false); return __builtin_bit_cast(float, r[0]) + __builtin_bit_cast(float, r[1]); }

struct Args {
    const float* x; const int* pos; const float* mix_pre; const float* mix_post; const float* ffn_pre; const float* ffn_post;
    const float* w_gu; const float* w_dn; const float* w_in; const float* conv_w; const float* w_out; const float* kv_norm; const float* w_kv; const float* w_q; const float* w_o;
    float* out; unsigned char* ws; int ph_lo, ph_hi;
};

__device__ __forceinline__ void transpose_item(const float* W, int ldw, int src0, int hstride, int k0, const float* gain, float scale, bf16_t* WT, int K, int n0, LAS unsigned char* scr, int lane) {
    const int q = lane >> 4, c = lane & 15;
    const float* wp = W + (size_t)(k0 + 16 * q) * ldw + src0 + (c >> 3) * hstride + (c & 7) * 4;
    f32x4 v[16];
#pragma unroll
    for (int j = 0; j < 16; ++j) v[j] = *(const f32x4*)(wp + (size_t)j * ldw);
    f32x4 gv[4];
#pragma unroll
    for (int j = 0; j < 4; ++j) gv[j] = gain ? *(const f32x4*)(gain + k0 + 16 * q + 4 * j) * scale : (f32x4){scale, scale, scale, scale};
#pragma unroll
    for (int j = 0; j < 16; ++j) v[j] = v[j] * gv[j >> 2][j & 3];
#pragma unroll
    for (int i = 0; i < 4; ++i) {
        u32x4 lo, hi;
        lo.x = pk2(v[0][i], v[1][i]); lo.y = pk2(v[2][i], v[3][i]); lo.z = pk2(v[4][i], v[5][i]); lo.w = pk2(v[6][i], v[7][i]);
        hi.x = pk2(v[8][i], v[9][i]); hi.y = pk2(v[10][i], v[11][i]); hi.z = pk2(v[12][i], v[13][i]); hi.w = pk2(v[14][i], v[15][i]);
        LAS u32x4* d = (LAS u32x4*)(scr + (4 * c + i) * 144 + 32 * q);
        d[0] = lo; d[1] = hi;
    }
    asm volatile("s_waitcnt lgkmcnt(0)" ::: "memory");
#pragma unroll
    for (int it = 0; it < 8; ++it) { const int n = (lane >> 3) + 8 * it, ch = lane & 7;
        const u32x4 o = *(const LAS u32x4*)(scr + n * 144 + 16 * ch);
        *(u32x4*)(WT + (size_t)(n0 + n) * K + k0 + 8 * ch) = o; }
    asm volatile("s_waitcnt lgkmcnt(0)" ::: "memory");
}

template <int MODE>
__device__ __forceinline__ void row_pass(const float* base, const float* y, const float* g, float* hout, bf16_t* xn, int gw, int NGW, int lane) {
    for (int m = gw; m < M; m += NGW) {
        f32x4 v[4];
        if (MODE == 0) {
#pragma unroll
            for (int j = 0; j < 4; ++j) v[j] = ((const f32x4*)(base + (size_t)m * D))[64 * j + lane];
        } else {
            f32x4 yy[4]; float s = 0.f;
#pragma unroll
            for (int j = 0; j < 4; ++j) { yy[j] = ((const f32x4*)(y + (size_t)m * D))[64 * j + lane]; s += (yy[j].x * yy[j].x + yy[j].y * yy[j].y) + (yy[j].z * yy[j].z + yy[j].w * yy[j].w); }
            const float rs = 1.0f / sqrtf(wave_sum(s, lane) * (1.0f / D) + RMS_EPS);
#pragma unroll
            for (int j = 0; j < 4; ++j) { const f32x4 b = ((const f32x4*)(base + (size_t)m * D))[64 * j + lane]; const f32x4 gg = ((const f32x4*)g)[64 * j + lane];
                v[j] = b + yy[j] * rs * gg; ((f32x4*)(hout + (size_t)m * D))[64 * j + lane] = v[j]; }
        }
        if (MODE != 2) {
            float s = 0.f;
#pragma unroll
            for (int j = 0; j < 4; ++j) s += (v[j].x * v[j].x + v[j].y * v[j].y) + (v[j].z * v[j].z + v[j].w * v[j].w);
            const float rs = 1.0f / sqrtf(wave_sum(s, lane) * (1.0f / D) + RMS_EPS);
#pragma unroll
            for (int j = 0; j < 4; ++j) { u32x2 o; o.x = pk2(v[j].x * rs, v[j].y * rs); o.y = pk2(v[j].z * rs, v[j].w * rs); ((u32x2*)(xn + (size_t)m * D))[64 * j + lane] = o; }
        }
    }
}

__device__ __forceinline__ int crow(int r, int hi) { return (r & 3) + 8 * (r >> 2) + 4 * hi; }
__device__ __forceinline__ unsigned cvtpk(float lo, float hi) { typedef __bf16 bf2 __attribute__((ext_vector_type(2))); f32x2 v = {lo, hi}; bf2 b = __builtin_convertvector(v, bf2); return __builtin_bit_cast(unsigned, b); }
typedef short v4i16_t __attribute__((ext_vector_type(4)));
__device__ __forceinline__ s16x4 vtr(const LAS unsigned char* p) { return __builtin_bit_cast(s16x4, __builtin_amdgcn_ds_read_tr16_b64_v4i16((LAS v4i16_t*)p)); }

constexpr int ATT_VOFF = 384 * 128, ATT_OST = 2 * 384 * 128, ATT_SL = RING_BYTES + 1024;
struct AttUnit { int rowbase, col, lsecol, r, cc; };
__device__ __forceinline__ AttUnit att_decode(int un, int g, int dil) {
    AttUnit u; const int c16 = un & 15, h = (un >> 4) & 15, b = un >> 8; const int Lq = SEQ / dil / 256;
    u.r = c16 / Lq; u.cc = c16 - u.r * Lq; u.rowbase = b * SEQ; u.col = h * HD; u.lsecol = g * NH + h; return u;
}
__device__ __forceinline__ void attn_branch(const bf16_t* Kb, const bf16_t* Vb, bf16_t* QOb, float* lse, int g, int vcu, int G, LAS unsigned char* lds, int tid) {
    const int lane = tid & 63, wave = __builtin_amdgcn_readfirstlane(tid >> 6), r32 = lane & 31, hi = lane >> 5;
    const int dil = (g == 0) ? 1 : (g == 1 ? 4 : 16);
    constexpr int NUNITS = BATCH * NH * 16;
    const float NEG = -1e30f;
    const int skey = tid >> 3, sch = tid & 7;
    u32x4 pk[6], pv[6];
#define ATT_ISSUE(U) do { _Pragma("unroll") for (int it = 0; it < 6; ++it) { const int Pk = 256 * (U).cc - 128 + 64 * it + skey; \
        if (Pk >= 0) { const size_t off = (size_t)((U).rowbase + (U).r + dil * Pk) * D + (U).col + sch * 8; pk[it] = *(const u32x4*)(Kb + off); pv[it] = *(const u32x4*)(Vb + off); } } } while (0)
#define ATT_WRITE() do { _Pragma("unroll") for (int it = 0; it < 6; ++it) { const int key = 64 * it + skey; \
        *(LAS u32x4*)(lds + key * 128 + ((sch ^ ((key >> 1) & 7)) << 4)) = pk[it]; \
        *(LAS u32x4*)(lds + ATT_VOFF + (sch >> 2) * (384 * 64) + key * 64 + ((sch & 3) << 4)) = pv[it]; } } while (0)
    int un = vcu;
    if (un >= NUNITS) return;
    AttUnit cur = att_decode(un, g, dil);
    ATT_ISSUE(cur); ATT_WRITE();
    __syncthreads();
    for (;;) {
        const int nun = un + G; const bool has_next = nun < NUNITS;
        AttUnit nxt = cur; if (has_next) { nxt = att_decode(nun, g, dil); ATT_ISSUE(nxt); }
        const int P0 = 256 * cur.cc + 32 * wave;
        bf16x8 qf[4];
        { const bf16_t* qrow = QOb + (size_t)(cur.rowbase + cur.r + dil * (P0 + r32)) * D + cur.col + hi * 8;
#pragma unroll
          for (int s = 0; s < 4; ++s) qf[s] = *(const bf16x8*)(qrow + 16 * s); }
        const int kt0 = (P0 >= 128) ? 0 : (4 - (P0 >> 5));
        f32x16 st[5];
#pragma unroll
        for (int kt = 0; kt < 5; ++kt) {
            if (kt >= kt0) {
                const int key = 32 * wave + 32 * kt + r32; const LAS unsigned char* kp = lds + key * 128; const int sw = (key >> 1) & 7;
                f32x16 acc = {};
#pragma unroll
                for (int s = 0; s < 4; ++s) { const bf16x8 kf = *(const LAS bf16x8*)(kp + (((2 * s + hi) ^ sw) << 4)); acc = __builtin_amdgcn_mfma_f32_32x32x16_bf16(kf, qf[s], acc, 0, 0, 0); }
                st[kt] = acc;
            } else {
#pragma unroll
                for (int i = 0; i < 16; ++i) st[kt][i] = NEG;
            }
        }
#pragma unroll
        for (int i = 0; i < 16; ++i) { const int kl = crow(i, hi); if (kl < r32) st[0][i] = NEG; if (kl > r32) st[4][i] = NEG; }
        float mx = NEG;
#pragma unroll
        for (int kt = 0; kt < 5; ++kt)
#pragma unroll
            for (int i = 0; i < 16; ++i) mx = fmaxf(mx, st[kt][i]);
        mx = fmaxf(mx, __shfl_xor(mx, 32));
        float l = 0.f;
#pragma unroll
        for (int kt = 0; kt < 5; ++kt)
#pragma unroll
            for (int i = 0; i < 16; ++i) { const float p = __builtin_amdgcn_exp2f(st[kt][i] - mx); st[kt][i] = p; l += p; }
        l += __shfl_xor(l, 32);
        f32x16 o[2]; o[0] = f32x16{}; o[1] = f32x16{};
        const LAS unsigned char* trb = lds + ATT_VOFF + (32 * wave + 4 * hi + ((lane & 15) >> 2)) * 64 + ((lane >> 4) & 1) * 32 + (lane & 3) * 8;
#pragma unroll
        for (int kt = 0; kt < 5; ++kt) {
            if (kt >= kt0) {
#pragma unroll
                for (int s = 0; s < 2; ++s) {
                    u32x4 pw; pw.x = cvtpk(st[kt][8 * s + 0], st[kt][8 * s + 1]); pw.y = cvtpk(st[kt][8 * s + 2], st[kt][8 * s + 3]);
                    pw.z = cvtpk(st[kt][8 * s + 4], st[kt][8 * s + 5]); pw.w = cvtpk(st[kt][8 * s + 6], st[kt][8 * s + 7]);
                    const bf16x8 pa = __builtin_bit_cast(bf16x8, pw);
#pragma unroll
                    for (int db = 0; db < 2; ++db) {
                        const LAS unsigned char* tp = trb + db * (384 * 64) + kt * 2048 + s * 1024;
                        const s16x4 lo = vtr(tp), hh = vtr(tp + 512);
                        const bf16x8 vf = (bf16x8){lo[0], lo[1], lo[2], lo[3], hh[0], hh[1], hh[2], hh[3]};
                        o[db] = __builtin_amdgcn_mfma_f32_32x32x16_bf16(pa, vf, o[db], 0, 0, 0);
                    }
                }
            }
        }
        LAS float* sl = (LAS float*)(lds + ATT_SL + wave * 256);
        if (hi == 0) { sl[r32] = __builtin_amdgcn_rcpf(l);
            lse[(size_t)(cur.rowbase + cur.r + dil * (P0 + r32)) * 48 + cur.lsecol] = mx + __builtin_amdgcn_logf(l); }
        LAS bf16_t* stg = (LAS bf16_t*)(lds + ATT_OST + wave * 4096);
#pragma unroll
        for (int i = 0; i < 16; ++i) { const int q = crow(i, hi); const float rl = sl[q];
            stg[q * 64 + r32] = (bf16_t)f2bf(o[0][i] * rl); stg[q * 64 + 32 + r32] = (bf16_t)f2bf(o[1][i] * rl); }
#pragma unroll
        for (int it = 0; it < 4; ++it) { const int row = it * 8 + (lane >> 3), ch = lane & 7;
            const u32x4 v = *(const LAS u32x4*)(stg + row * 64 + ch * 8);
            *(u32x4*)(QOb + (size_t)(cur.rowbase + cur.r + dil * (P0 + row)) * D + cur.col + ch * 8) = v; }
        if (!has_next) break;
        __syncthreads();
        ATT_WRITE();
        __syncthreads();
        cur = nxt; un = nun;
    }
#undef ATT_ISSUE
#undef ATT_WRITE
}

constexpr int N_PHASES = 20;
__global__ void __launch_bounds__(NWAVES * 64, 2) yoco_fwd(Args a_) {
    extern __shared__ __attribute__((aligned(16))) unsigned char lds_raw[];
    {
        LAS unsigned char* lds0 = (LAS unsigned char*)lds_raw;
        for (int u = threadIdx.x; u < (LDS_BYTES - RING_BYTES) / 4; u += NWAVES * 64) ((LAS unsigned*)(lds0 + RING_BYTES))[u] = 0u;
        __syncthreads();
        if (!MK_PER_PHASE) (void)xcd_barrier_post((unsigned*)(a_.ws + WS_CTL) + 1024, (volatile LAS unsigned*)(lds0 + MISC_OFF) + 8);
    }
    const int ph_hi = a_.ph_hi;
    for (int ph = a_.ph_lo; ph < ph_hi; ++ph) {
        const __attribute__((address_space(4))) Args* ap = (const __attribute__((address_space(4))) Args*)__builtin_amdgcn_kernarg_segment_ptr(); asm volatile("" : "+s"(ap));
        Args a;
        a.x = ap->x; a.pos = ap->pos; a.mix_pre = ap->mix_pre; a.mix_post = ap->mix_post; a.ffn_pre = ap->ffn_pre; a.ffn_post = ap->ffn_post; a.w_gu = ap->w_gu; a.w_dn = ap->w_dn;
        a.w_in = ap->w_in; a.conv_w = ap->conv_w; a.w_out = ap->w_out; a.kv_norm = ap->kv_norm; a.w_kv = ap->w_kv; a.w_q = ap->w_q; a.w_o = ap->w_o; a.out = ap->out; a.ws = ap->ws;
        unsigned char* ws = a.ws; asm volatile("" : "+s"(ws));
        int tid = threadIdx.x; asm volatile("" : "+v"(tid));
        int G = gridDim.x, bx = blockIdx.x; asm volatile("" : "+s"(G), "+s"(bx));
        LAS unsigned char* lds = (LAS unsigned char*)lds_raw;
        const int lane = tid & 63, wave = __builtin_amdgcn_readfirstlane(tid >> 6);
        const int vcu = (G % 8 == 0) ? (bx % 8) * (G / 8) + bx / 8 : bx;
        const int gw = vcu * NWAVES + wave, NGW = G * NWAVES;
        float* rope = (float*)(ws + WS_ROPE);
        bf16_t* XN = (bf16_t*)(ws + WS_XN);
        float* Y = (float*)(ws + WS_Y);
        bf16_t* ACT = (bf16_t*)(ws + WS_ACT);
        bf16_t* Ubuf = (bf16_t*)(ws + WS_ACT);
        bf16_t* Bbuf = (bf16_t*)(ws + WS_ACT + 32 * MiB);
        float* LSE = (float*)(ws + WS_LSE);
        const int layer = ph >= 8 ? 1 : 0;
        const int g = (ph - 8) >> 1;

        if (EN_P0 && ph == 0) {
            LAS unsigned char* scr = lds + wave * 16384;
            constexpr int I_IN = 16 * 48, I_OUT = 16 * 16, I_GU = 16 * 88, I_DN = 44 * 16, I_KVQ = 16 * 144, I_O = 16 * 16;
            constexpr int NITEMS = I_IN + I_OUT + 2 * I_GU + 2 * I_DN + I_KVQ + I_O;
            for (int it = gw; it < NITEMS; it += NGW) {
                int q = it, kb, n0, srcc, ldw, K = 1024, hs = 32; const float* W; const float* gain = nullptr; float scale = 1.0f; size_t wto;
                if (q < I_IN) { kb = q / 48; n0 = 64 * (q % 48);
                    if (n0 < 1024) srcc = n0; else { const int qq = n0 - 1024, j = qq >> 8, w = qq & 255; srcc = (w < 128 ? 1024 : 2048) + 128 * j + (w & 127); }
                    W = a.w_in; ldw = 3072; gain = a.mix_pre; wto = WS_WIN; }
                else if ((q -= I_IN) < I_OUT) { kb = q / 16; n0 = 64 * (q % 16); srcc = n0; W = a.w_out; ldw = 1024; wto = WS_WOUT; }
                else if ((q -= I_OUT) < 2 * I_GU) { const int ly = q / I_GU; q -= ly * I_GU; kb = q / 88; n0 = 64 * (q % 88); const int j = n0 >> 8, w = n0 & 255;
                    srcc = (w < 128 ? 0 : DFF) + 128 * j + (w & 127); W = a.w_gu + (size_t)ly * D * 2 * DFF; ldw = 2 * DFF; gain = a.ffn_pre + ly * D; wto = ly ? WS_WGU1 : WS_WGU0; }
                else if ((q -= 2 * I_GU) < 2 * I_DN) { const int ly = q / I_DN; q -= ly * I_DN; kb = q / 16; n0 = 64 * (q % 16); srcc = n0;
                    W = a.w_dn + (size_t)ly * DFF * D; ldw = 1024; K = DFF; wto = ly ? WS_WDN1 : WS_WDN0; }
                else if ((q -= 2 * I_DN) < I_KVQ) { kb = q / 144; n0 = 64 * (q % 144); const int gg = n0 / NQ, rr = n0 - gg * NQ, part = rr >> 10, tile = (rr >> 8) & 3, w = rr & 255, bj = w >> 7, hl = (w & 127) >> 5;
                    srcc = (gg * NH + 4 * tile + hl) * HD + 32 * bj; hs = 64; wto = WS_WKVQ;
                    if (part == 2) { W = a.w_q; ldw = NQ; gain = a.mix_pre + D; scale = QSCALE; } else { W = a.w_kv; ldw = 2 * NQ; srcc += part * NQ; gain = a.kv_norm; } }
                else { q -= I_KVQ; kb = q / 16; n0 = 64 * (q % 16); srcc = n0; W = a.w_o; ldw = 1024; wto = WS_WO; }
                transpose_item(W, ldw, srcc, hs, 64 * kb, gain, scale, (bf16_t*)(ws + wto), K, n0, scr, lane);
            }
            for (int e = gw * 64 + lane; e < M * 32; e += NGW * 64) {
                const int m = e >> 5, i = e & 31;
                const float inv = exp2f((float)i * -0.41524101186092033f);
                const float ang = (float)a.pos[m] * inv;
                const float kq = rintf(ang * 0.63661977236758134308f);
                float yv = fmaf(-kq, 1.57079637050628662109375f, ang);
                yv = fmaf(-kq, -4.37113900018624283e-8f, yv);
                yv = fmaf(-kq, -1.71512449851278e-15f, yv);
                const float y2 = yv * yv;
                const float sn = yv + yv * y2 * (-1.6666654611e-1f + y2 * (8.3321608736e-3f + y2 * -1.9515295891e-4f));
                const float cs = 1.0f - 0.5f * y2 + y2 * y2 * (4.166664568298827e-2f + y2 * (-1.388731625493765e-3f + y2 * 2.443315711809948e-5f));
                const int qd = ((int)kq) & 3;
                const float c = (qd == 0) ? cs : (qd == 1) ? -sn : (qd == 2) ? -cs : sn;
                const float s = (qd == 0) ? sn : (qd == 1) ? cs : (qd == 2) ? -sn : -cs;
                rope[(size_t)m * 64 + i] = c; rope[(size_t)m * 64 + 32 + i] = s;
            }
            row_pass<0>(a.x, nullptr, nullptr, nullptr, XN, gw, NGW, lane);
        } else if (EN_G1 && ph == 1) {
            pg8::Gemm g{XN, (const bf16_t*)(ws + WS_WIN), M, 3072, 1024}; pg8::StaticOrder S; S.init(M, 3072, G, bx);
            pg8::EpiConvIn E{Bbuf, Ubuf};
            pg8::gemm_phase<pg8::EpiConvIn, pg8::StaticOrder, true, true>(lds, g, S, E, tid);
        } else if (EN_CONV && ph == 2) {
            const int c8 = tid & 127, sub = tid >> 7;
            const float* cw = a.conv_w;
            float w0[8], w1[8], w2[8];
#pragma unroll
            for (int i = 0; i < 8; ++i) { w0[i] = cw[c8 * 8 + i]; w1[i] = cw[D + c8 * 8 + i]; w2[i] = cw[2 * D + c8 * 8 + i]; }
            for (int blk = vcu; blk < M / 64; blk += G) {
                const int m0 = blk * 64 + sub * 16; const int t0 = m0 & (SEQ - 1);
                u32x4 um2 = (u32x4){0u, 0u, 0u, 0u}, um1 = (u32x4){0u, 0u, 0u, 0u};
                if (t0 >= 2) { um2 = *(const u32x4*)(Ubuf + (size_t)(m0 - 2) * D + c8 * 8); um1 = *(const u32x4*)(Ubuf + (size_t)(m0 - 1) * D + c8 * 8); }
#pragma unroll 4
                for (int rr = 0; rr < 16; ++rr) {
                    const size_t off = (size_t)(m0 + rr) * D + c8 * 8;
                    const u32x4 u0 = *(const u32x4*)(Ubuf + off); const u32x4 bb = *(const u32x4*)(Bbuf + off);
                    u32x4 o;
#pragma unroll
                    for (int k = 0; k < 4; ++k) {
                        const float cl = w0[2 * k] * bf_lo(um2[k]) + w1[2 * k] * bf_lo(um1[k]) + w2[2 * k] * bf_lo(u0[k]);
                        const float ch = w0[2 * k + 1] * bf_hi(um2[k]) + w1[2 * k + 1] * bf_hi(um1[k]) + w2[2 * k + 1] * bf_hi(u0[k]);
                        o[k] = pk2(cl * bf_lo(bb[k]), ch * bf_hi(bb[k]));
                    }
                    *(u32x4*)(XN + off) = o;
                    um2 = um1; um1 = u0;
                }
            }
        } else if (EN_GF32 && (ph == 3 || ph == 15 || ph == 6 || ph == 18)) {
            const bool dn = (ph == 6 || ph == 18);
            const bf16_t* A = dn ? ACT : XN;
            const size_t wo = (ph == 3) ? WS_WOUT : (ph == 15) ? WS_WO : (ph == 6) ? WS_WDN0 : WS_WDN1;
            pg8::Gemm g{A, (const bf16_t*)(ws + wo), M, 1024, dn ? DFF : 1024}; pg8::StaticOrder S; S.init(M, 1024, G, bx);
            pg8::EpiF32 E{Y, D};
            pg8::gemm_phase<pg8::EpiF32, pg8::StaticOrder, false, true>(lds, g, S, E, tid);
        } else if (EN_ROW && (ph == 4 || ph == 16 || ph == 7)) {
            const float* base = (ph == 4) ? a.x : a.out;
            const float* gain = (ph == 4) ? a.mix_post : (ph == 16) ? a.mix_post + D : a.ffn_post;
            row_pass<1>(base, Y, gain, a.out, XN, gw, NGW, lane);
        } else if (EN_ROW && ph == 19) {
            row_pass<2>(a.out, Y, a.ffn_post + D, a.out, nullptr, gw, NGW, lane);
        } else if (EN_UP && (ph == 5 || ph == 17)) {
            pg8::Gemm g{XN, (const bf16_t*)(ws + (layer ? WS_WGU1 : WS_WGU0)), M, 2 * DFF, 1024}; pg8::StaticOrder S; S.init(M, 2 * DFF, G, bx);
            pg8::EpiSwiGLU E{ACT};
            pg8::gemm_phase<pg8::EpiSwiGLU, pg8::StaticOrder, true, true>(lds, g, S, E, tid);
        } else if (EN_KVQ && (ph == 8 || ph == 10 || ph == 12)) {
            pg8::Gemm gm{XN, (const bf16_t*)(ws + WS_WKVQ) + (size_t)g * NQ * D, M, NQ, 1024}; pg8::StaticOrder S; S.init(M, NQ, G, bx);
            pg8::EpiKVQ E{(bf16_t*)(ws + WS_K), g, rope};
            pg8::gemm_phase<pg8::EpiKVQ, pg8::StaticOrder, true, true>(lds, gm, S, E, tid);
        } else if (EN_ATT && (ph == 9 || ph == 11 || ph == 13)) {
            attn_branch((const bf16_t*)(ws + WS_K), (const bf16_t*)(ws + WS_V), (bf16_t*)(ws + WS_QO) + (size_t)g * M * D, LSE, g, vcu, G, lds, tid);
        } else if (EN_MIX && ph == 14) {
            const bf16_t* QO = (const bf16_t*)(ws + WS_QO);
            for (int m = gw; m < M; m += NGW) {
                const int h = lane >> 2, dp = (lane & 3) * 16;
                const float l0 = LSE[(size_t)m * 48 + h], l1 = LSE[(size_t)m * 48 + 16 + h], l2 = LSE[(size_t)m * 48 + 32 + h];
                const float mx = fmaxf(l0, fmaxf(l1, l2));
                float w0 = __builtin_amdgcn_exp2f(l0 - mx), w1 = __builtin_amdgcn_exp2f(l1 - mx), w2 = __builtin_amdgcn_exp2f(l2 - mx);
                const float inv = 1.0f / (w0 + w1 + w2); w0 *= inv; w1 *= inv; w2 *= inv;
                const bf16_t* op = QO + (size_t)m * D + h * HD + dp;
#pragma unroll
                for (int q = 0; q < 2; ++q) {
                    const u32x4 a0 = *(const u32x4*)(op + 8 * q), a1 = *(const u32x4*)(op + (size_t)M * D + 8 * q), a2 = *(const u32x4*)(op + 2 * (size_t)M * D + 8 * q);
                    u32x4 o;
#pragma unroll
                    for (int k = 0; k < 4; ++k) o[k] = pk2(w0 * bf_lo(a0[k]) + w1 * bf_lo(a1[k]) + w2 * bf_lo(a2[k]), w0 * bf_hi(a0[k]) + w1 * bf_hi(a1[k]) + w2 * bf_hi(a2[k]));
                    *(u32x4*)(XN + (size_t)m * D + h * HD + dp + 8 * q) = o;
                }
            }
        }
        if (ph + 1 < ph_hi) { XcdBarrier bar; bar.bar = (unsigned*)(ws + WS_CTL) + 1024; bar.x = xb_xcc_id(); bar.st = (volatile LAS unsigned*)(lds + MISC_OFF) + 8; xcd_barrier(bar); }
    }
}

extern "C" void kernel_launch(void* const* d_in, const int* in_sizes, int n_in, void* d_out, int out_size, void* d_ws, size_t ws_size, hipStream_t stream) {
    static int grid = 0;
    if (grid == 0) {
        if (n_in != 15 || out_size != M * D || ws_size < WS_END) { fprintf(stderr, "kernel_launch: unexpected shapes (n_in %d, out %d, ws %zu)\n", n_in, out_size, ws_size); grid = -1; return; }
        int dev = 0, cus = 0;
        if (hipGetDevice(&dev) != hipSuccess || hipDeviceGetAttribute(&cus, hipDeviceAttributeMultiprocessorCount, dev) != hipSuccess) { grid = -1; return; }
        if (hipFuncSetAttribute((const void*)yoco_fwd, hipFuncAttributeMaxDynamicSharedMemorySize, LDS_BYTES) != hipSuccess) { fprintf(stderr, "kernel_launch: hipFuncSetAttribute failed\n"); grid = -1; return; }
        int per_cu = 0;
        (void)hipOccupancyMaxActiveBlocksPerMultiprocessor(&per_cu, (const void*)yoco_fwd, NWAVES * 64, LDS_BYTES);
        (void)hipGetLastError();
        grid = cus;
    }
    if (grid < 0) return;
    (void)hipMemsetAsync((char*)d_ws + WS_CTL, 0, CTL_ZERO_BYTES, stream);
    Args a{};
    a.x = (const float*)d_in[0]; a.pos = (const int*)d_in[1]; a.mix_pre = (const float*)d_in[2]; a.mix_post = (const float*)d_in[3];
    a.ffn_pre = (const float*)d_in[4]; a.ffn_post = (const float*)d_in[5]; a.w_gu = (const float*)d_in[6]; a.w_dn = (const float*)d_in[7];
    a.w_in = (const float*)d_in[8]; a.conv_w = (const float*)d_in[9]; a.w_out = (const float*)d_in[10]; a.kv_norm = (const float*)d_in[11];
    a.w_kv = (const float*)d_in[12]; a.w_q = (const float*)d_in[13]; a.w_o = (const float*)d_in[14];
    a.out = (float*)d_out; a.ws = (unsigned char*)d_ws;
#if MK_PER_PHASE
#ifndef REPEAT_MASK
#define REPEAT_MASK 0
#endif
    for (int p = 0; p < N_PHASES; ++p) {
        a.ph_lo = p; a.ph_hi = p + 1; hipLaunchKernelGGL(yoco_fwd, dim3(grid), dim3(NWAVES * 64), LDS_BYTES, stream, a);
        if ((REPEAT_MASK >> p) & 1) for (int rep = 0; rep < 2; ++rep) {
            if (p == 9 || p == 12) { a.ph_lo = p - 1; a.ph_hi = p; hipLaunchKernelGGL(yoco_fwd, dim3(grid), dim3(NWAVES * 64), LDS_BYTES, stream, a); a.ph_lo = p; a.ph_hi = p + 1; }
            hipLaunchKernelGGL(yoco_fwd, dim3(grid), dim3(NWAVES * 64), LDS_BYTES, stream, a);
        }
    }
#else
    a.ph_lo = 0; a.ph_hi = N_PHASES;
    hipLaunchKernelGGL(yoco_fwd, dim3(grid), dim3(NWAVES * 64), LDS_BYTES, stream, a);
#endif
}
```
